# Optimizing an MI355X kernel written in HIP

```python
import math
import jax
import jax.numpy as jnp
from jax import lax
import numpy as np

D_MODEL = 2048
BATCH = 1
SEQ = 8192
DEPTH = 4

GRID_W = 64
CTX_LEN = 256
ROPE_THETA = 10000.0
NORM_EPS = 1e-6
Q_BLOCK = 128

A_HEADS = 4
A_KV_HEADS = 2
A_HEAD_DIM = 128
A_WIDTH = A_HEADS * A_HEAD_DIM
A_KV_WIDTH = A_KV_HEADS * A_HEAD_DIM
LRU_WIDTH = 512
LRU_BLOCKS = 4
LRU_CONV = 4
LRU_C = 8.0
DN_HEADS = 4
DN_HEAD_DIM = 128
DN_WIDTH = DN_HEADS * DN_HEAD_DIM
DN_CONV = 4
DN_CHUNK = 64
MLA_HEADS = 4
MLA_Q_RANK = 384
MLA_KV_RANK = 256
MLA_NOPE = 128
MLA_ROPE = 64
MLA_V = 128
MLA_WIDTH = MLA_HEADS * MLA_V

MIX_WIDTH = A_WIDTH + LRU_WIDTH + DN_WIDTH + MLA_WIDTH
IN_SPLITS = (
    A_WIDTH, A_KV_WIDTH, A_KV_WIDTH, A_WIDTH,
    LRU_WIDTH, LRU_WIDTH,
    3 * DN_WIDTH, DN_WIDTH, 4 * DN_HEADS,
    MLA_Q_RANK, MLA_KV_RANK, MLA_ROPE, MLA_WIDTH,
)
IN_WIDTH = sum(IN_SPLITS)

kernel_name = 'hybrid_parallel_heads_dit_block'


def _rms_norm(x, w):
    xf = x.astype(jnp.float32)
    y = xf * lax.rsqrt(jnp.mean(xf * xf, axis=-1, keepdims=True) + NORM_EPS)
    return (y * w).astype(x.dtype)


def _l2_norm(x):
    return x * lax.rsqrt(jnp.sum(x * x, axis=-1, keepdims=True) + NORM_EPS)


def _split_heads(x, n):
    b, t, _ = x.shape
    return x.reshape(b, t, n, -1).transpose(0, 2, 1, 3)


def _merge_heads(x):
    b, n, t, d = x.shape
    return x.transpose(0, 2, 1, 3).reshape(b, t, n * d)


def _rope_1d(x, pos):
    half = x.shape[-1] // 2
    inv_freq = ROPE_THETA ** (-jnp.arange(half, dtype=jnp.float32) / half)
    ang = pos.astype(jnp.float32)[:, None] * inv_freq
    cos, sin = jnp.cos(ang), jnp.sin(ang)
    x1, x2 = x[..., :half], x[..., half:]
    return jnp.concatenate([x1 * cos - x2 * sin, x1 * sin + x2 * cos], axis=-1).astype(x.dtype)


def _rope_2d(x, rows, cols):
    half = x.shape[-1] // 2
    return jnp.concatenate([_rope_1d(x[..., :half], rows), _rope_1d(x[..., half:], cols)], axis=-1)


def _attend(q, k, v, scale):
    s = jnp.einsum('bkgqd,bktd->bkgqt', q, k).astype(jnp.float32) * scale
    p = jax.nn.softmax(s, axis=-1).astype(v.dtype)
    return jnp.einsum('bkgqt,bktd->bkgqd', p, v)


def _blocked_attention(q, k, v, scale):
    b, hk, g, s, d = q.shape
    nb = s // Q_BLOCK
    qb = jnp.moveaxis(q.reshape(b, hk, g, nb, Q_BLOCK, d), 3, 0)
    ob = lax.map(lambda qi: _attend(qi, k, v, scale), qb)
    return jnp.moveaxis(ob, 0, 3).reshape(b, hk, g, s, v.shape[-1])


def _dwconv_centred(x, w):
    k_w = w.shape[0]
    left = k_w // 2
    t = x.shape[1]
    xp = jnp.pad(x, ((0, 0), (left, k_w - 1 - left), (0, 0)))
    y = xp[:, 0:t] * w[0]
    for j in range(1, k_w):
        y = y + xp[:, j:j + t] * w[j]
    return y


def _block_diag(x, w):
    b, t, _ = x.shape
    nb, bw, _ = w.shape
    return jnp.einsum('btnj,njk->btnk', x.reshape(b, t, nb, bw), w).reshape(b, t, nb * bw)


def _lin_combine(left, right):
    a1, b1 = left
    a2, b2 = right
    return a1 * a2, a2 * b1 + b2


def _lru_scan(a, b, h0):
    a_cum, h = lax.associative_scan(_lin_combine, (a, b), axis=1)
    h = h + a_cum * h0[:, None]
    return h, h[:, -1]


def _gated_delta_chunked(q, k, v, g, beta, h0):
    b, h, t, dk = q.shape
    dv = v.shape[-1]
    c = DN_CHUNK
    n = t // c

    def chunks(a):
        return a.reshape(a.shape[:2] + (n, c) + a.shape[3:])

    q = chunks(q * dk ** -0.5)
    k = chunks(k)
    v = chunks(v)
    beta = chunks(beta)
    g = jnp.cumsum(chunks(g), axis=-1)
    idx = jnp.arange(c)
    incl = idx[:, None] >= idx[None, :]
    strict = idx[:, None] > idx[None, :]
    decay = jnp.exp(jnp.where(incl, g[..., :, None] - g[..., None, :], -jnp.inf))
    kb = k * beta[..., None]
    lower = jnp.where(strict, jnp.einsum('bhncd,bhnsd->bhncs', kb, k) * decay, 0.0)
    eye = jnp.eye(c, dtype=lower.dtype)
    rhs = jnp.concatenate([v * beta[..., None], kb * jnp.exp(g)[..., None]], axis=-1)
    sol = lax.linalg.triangular_solve(lower + eye, rhs, left_side=True, lower=True, unit_diagonal=True)
    u, w = sol[..., :dv], sol[..., dv:]
    qk = jnp.where(incl, jnp.einsum('bhncd,bhnsd->bhncs', q, k) * decay, 0.0)
    g_last = g[..., -1]
    k_dec = k * jnp.exp(g_last[..., None] - g)[..., None]
    q_dec = q * jnp.exp(g)[..., None]

    def step(s, inp):
        q_c, k_c, u_c, w_c, qk_c, gl_c = inp
        v_new = u_c - jnp.einsum('bhcd,bhde->bhce', w_c, s)
        o = jnp.einsum('bhcd,bhde->bhce', q_c, s) + jnp.einsum('bhcs,bhse->bhce', qk_c, v_new)
        s = s * jnp.exp(gl_c)[..., None, None] + jnp.einsum('bhcd,bhce->bhde', k_c, v_new)
        return s, o

    xs = tuple(jnp.moveaxis(a, 2, 0) for a in (q_dec, k_dec, u, w, qk, g_last))
    s_final, o = lax.scan(step, h0, xs)
    return jnp.moveaxis(o, 0, 2).reshape(b, h, t, dv), s_final


def _bidirectional(scan, ctx_fwd, lat_fwd, ctx_bwd, lat_bwd, h0, t_axis, need_ctx):
    def flip(args):
        return tuple(jnp.flip(a, t_axis) for a in args)

    yc_f, s_f = scan(*ctx_fwd, h0)
    yl_f, _ = scan(*lat_fwd, s_f)
    yc_b, s_b = scan(*flip(ctx_bwd), h0)
    yl_b, _ = scan(*flip(lat_bwd), s_b)
    y_lat = yl_f + jnp.flip(yl_b, t_axis)
    y_ctx = yc_f + jnp.flip(yc_b, t_axis) if need_ctx else None
    return y_lat, y_ctx


def _gqa_mixer(p, pc, qn, kn, rows, cols, need_ctx):
    uq, uk, uv, z = p
    ucq, uck, ucv, zc = pc
    b, s, _ = uq.shape
    grp = A_HEADS // A_KV_HEADS
    scale = A_HEAD_DIM ** -0.5
    q = _rope_2d(_rms_norm(_split_heads(uq, A_HEADS), qn), rows, cols)
    k = _rope_2d(_rms_norm(_split_heads(uk, A_KV_HEADS), kn), rows, cols)
    v = _split_heads(uv, A_KV_HEADS)
    kc = _rms_norm(_split_heads(uck, A_KV_HEADS), kn)
    vc = _split_heads(ucv, A_KV_HEADS)
    o = _blocked_attention(q.reshape(b, A_KV_HEADS, grp, s, A_HEAD_DIM),
                           jnp.concatenate([kc, k], axis=2), jnp.concatenate([vc, v], axis=2), scale)
    y = _merge_heads(o.reshape(b, A_HEADS, s, A_HEAD_DIM)) * jax.nn.silu(z)
    if not need_ctx:
        return y, None
    qc = _rms_norm(_split_heads(ucq, A_HEADS), qn)
    oc = _attend(qc.reshape(b, A_KV_HEADS, grp, -1, A_HEAD_DIM), kc, vc, scale)
    yc = _merge_heads(oc.reshape(b, A_HEADS, -1, A_HEAD_DIM)) * jax.nn.silu(zc)
    return y, yc


def _rglru_mixer(p, pc, conv_w, conv_b, w_a, b_a, w_x, b_x, lam, need_ctx):
    ux, z = p
    ucx, zc = pc
    xl = (_dwconv_centred(ux, conv_w) + conv_b).astype(jnp.float32)
    xc = (_dwconv_centred(ucx, conv_w) + conv_b).astype(jnp.float32)

    def gates(xs, d):
        r = jax.nn.sigmoid(_block_diag(xs, w_a[d]) + b_a[d])
        i = jax.nn.sigmoid(_block_diag(xs, w_x[d]) + b_x[d])
        log_a = -LRU_C * r * jax.nn.softplus(-lam[d])
        return jnp.exp(log_a), jnp.sqrt(-jnp.expm1(2.0 * log_a)) * (i * xs)

    h0 = jnp.zeros((ux.shape[0], LRU_WIDTH), jnp.float32)
    hl, hc = _bidirectional(_lru_scan, gates(xc, 0), gates(xl, 0), gates(xc, 1), gates(xl, 1),
                            h0, 1, need_ctx)
    y = hl.astype(ux.dtype) * jax.nn.silu(z)
    yc = hc.astype(ux.dtype) * jax.nn.silu(zc) if need_ctx else None
    return y, yc


def _deltanet_mixer(p, pc, conv_w, a_log, dt_bias, norm_w, need_ctx):
    def prep(uqkv, uab):
        b, t, _ = uqkv.shape
        qkv = jax.nn.silu(_dwconv_centred(uqkv, conv_w)).astype(jnp.float32)
        q, k, v = jnp.split(qkv, 3, axis=-1)
        q = _l2_norm(_split_heads(q, DN_HEADS))
        k = _l2_norm(_split_heads(k, DN_HEADS))
        v = _split_heads(v, DN_HEADS)
        ab = uab.astype(jnp.float32).reshape(b, t, 2, 2, DN_HEADS)
        beta = jax.nn.sigmoid(ab[..., 0, :]).transpose(2, 0, 3, 1)
        g = (-jnp.exp(a_log.astype(jnp.float32))[:, None, :, None]
             * jax.nn.softplus(ab[..., 1, :] + dt_bias).transpose(2, 0, 3, 1))
        return q, k, v, g, beta

    uqkv, z, uab = p
    ucqkv, zc, ucab = pc
    q, k, v, g, beta = prep(uqkv, uab)
    qc, kc, vc, gc, betac = prep(ucqkv, ucab)
    h0 = jnp.zeros((uqkv.shape[0], DN_HEADS, DN_HEAD_DIM, DN_HEAD_DIM), jnp.float32)
    ol, oc = _bidirectional(_gated_delta_chunked,
                            (qc, kc, vc, gc[0], betac[0]), (q, k, v, g[0], beta[0]),
                            (qc, kc, vc, gc[1], betac[1]), (q, k, v, g[1], beta[1]),
                            h0, 2, need_ctx)

    def out(o, zz):
        return _merge_heads(_rms_norm(o, norm_w).astype(zz.dtype) * jax.nn.silu(_split_heads(zz, DN_HEADS)))

    return out(ol, z), (out(oc, zc) if need_ctx else None)


def _mla_mixer(p, pc, q_norm_w, kv_norm_w, w_uq, w_ukv, qn, kn, rows, cols, need_ctx):
    def project_q(ucq):
        return _rms_norm(_split_heads(_rms_norm(ucq, q_norm_w) @ w_uq, MLA_HEADS), qn)

    def project_kv(uckv, ukr):
        kv = _split_heads(_rms_norm(uckv, kv_norm_w) @ w_ukv, MLA_HEADS)
        k_nope, v = kv[..., :MLA_NOPE], kv[..., MLA_NOPE:]
        k_rope = jnp.broadcast_to(ukr[:, None], k_nope.shape[:-1] + (MLA_ROPE,))
        k = _rms_norm(jnp.concatenate([k_nope, k_rope], axis=-1), kn)
        return k, v

    def rotate(t):
        return jnp.concatenate([t[..., :MLA_NOPE], _rope_2d(t[..., MLA_NOPE:], rows, cols)], axis=-1)

    ucq, uckv, ukr, z = p
    ccq, cckv, ckr, zc = pc
    scale = (MLA_NOPE + MLA_ROPE) ** -0.5
    q = rotate(project_q(ucq))
    k, v = project_kv(uckv, ukr)
    k = rotate(k)
    kc, vc = project_kv(cckv, ckr)
    o = _blocked_attention(q[:, :, None], jnp.concatenate([kc, k], axis=2),
                           jnp.concatenate([vc, v], axis=2), scale)[:, :, 0]
    y = _merge_heads(o) * jax.nn.silu(z)
    if not need_ctx:
        return y, None
    oc = _attend(project_q(ccq)[:, :, None], kc, vc, scale)[:, :, 0]
    return y, _merge_heads(oc) * jax.nn.silu(zc)


def _layer(x, ctx, c, c_ctx, rows, cols, need_ctx,
           norm_w, w_ada, b_ada, w_in, w_out, attn_q_norm, attn_k_norm,
           lru_conv_w, lru_conv_b, lru_w_a, lru_b_a, lru_w_x, lru_b_x, lru_lambda,
           dn_conv_w, dn_a_log, dn_dt_bias, dn_norm_w,
           mla_q_norm, mla_kv_norm, mla_w_uq, mla_w_ukv, mla_q_qk_norm, mla_k_qk_norm):
    shift, scale, gate = jnp.split(jax.nn.silu(c) @ w_ada + b_ada, 3, axis=-1)
    shift_c, scale_c, gate_c = jnp.split(jax.nn.silu(c_ctx) @ w_ada + b_ada, 3, axis=-1)
    h = _rms_norm(x, norm_w) * (1.0 + scale[:, None]) + shift[:, None]
    hc = _rms_norm(ctx, norm_w) * (1.0 + scale_c) + shift_c
    offsets = np.cumsum(IN_SPLITS)[:-1].tolist()
    p = jnp.split(h @ w_in, offsets, axis=-1)
    pc = jnp.split(hc @ w_in, offsets, axis=-1)
    y_a, yc_a = _gqa_mixer(p[0:4], pc[0:4], attn_q_norm, attn_k_norm, rows, cols, need_ctx)
    y_b, yc_b = _rglru_mixer(p[4:6], pc[4:6], lru_conv_w, lru_conv_b, lru_w_a, lru_b_a,
                             lru_w_x, lru_b_x, lru_lambda, need_ctx)
    y_c, yc_c = _deltanet_mixer(p[6:9], pc[6:9], dn_conv_w, dn_a_log, dn_dt_bias, dn_norm_w, need_ctx)
    y_d, yc_d = _mla_mixer(p[9:13], pc[9:13], mla_q_norm, mla_kv_norm, mla_w_uq, mla_w_ukv,
                           mla_q_qk_norm, mla_k_qk_norm, rows, cols, need_ctx)
    x = x + gate[:, None] * (jnp.concatenate([y_a, y_b, y_c, y_d], axis=-1) @ w_out)
    if need_ctx:
        ctx = ctx + gate_c * (jnp.concatenate([yc_a, yc_b, yc_c, yc_d], axis=-1) @ w_out)
    return x, ctx


def setup_inputs(seed: int = 0) -> dict:
    key = jax.random.key(seed)
    ks = iter(jax.random.split(key, 40))
    f32 = jnp.float32
    L = DEPTH

    def nrm(shape, scale):
        return scale * jax.random.normal(next(ks), shape, f32)

    def gain(shape):
        return 1.0 + nrm(shape, 0.01)

    u_lam = jax.random.uniform(next(ks), (L, 2, LRU_WIDTH), f32, 0.9, 0.999)
    dt = jnp.exp(jax.random.uniform(next(ks), (L, 2, DN_HEADS), f32, math.log(1e-3), math.log(1e-1)))
    bw = LRU_WIDTH // LRU_BLOCKS
    return {
        'x': nrm((BATCH, SEQ, D_MODEL), 1.0),
        'c': nrm((BATCH, D_MODEL), 1.0),
        'ctx': nrm((BATCH, CTX_LEN, D_MODEL), 1.0),
        'c_ctx': nrm((D_MODEL,), 1.0),
        'norm_w': gain((L, D_MODEL)),
        'w_ada': nrm((L, D_MODEL, 3 * D_MODEL), 0.5 * D_MODEL ** -0.5),
        'b_ada': nrm((L, 3 * D_MODEL), 0.01),
        'w_in': nrm((L, D_MODEL, IN_WIDTH), D_MODEL ** -0.5),
        'w_out': nrm((L, MIX_WIDTH, D_MODEL), MIX_WIDTH ** -0.5),
        'attn_q_norm': gain((L, A_HEAD_DIM)),
        'attn_k_norm': gain((L, A_HEAD_DIM)),
        'lru_conv_w': nrm((L, LRU_CONV, LRU_WIDTH), LRU_CONV ** -0.5),
        'lru_conv_b': nrm((L, LRU_WIDTH), 0.01),
        'lru_w_a': nrm((L, 2, LRU_BLOCKS, bw, bw), bw ** -0.5),
        'lru_b_a': nrm((L, 2, LRU_WIDTH), 0.01),
        'lru_w_x': nrm((L, 2, LRU_BLOCKS, bw, bw), bw ** -0.5),
        'lru_b_x': nrm((L, 2, LRU_WIDTH), 0.01),
        'lru_lambda': jnp.log(u_lam) - jnp.log1p(-u_lam),
        'dn_conv_w': nrm((L, DN_CONV, 3 * DN_WIDTH), DN_CONV ** -0.5),
        'dn_a_log': jnp.log(jax.random.uniform(next(ks), (L, 2, DN_HEADS), f32, 1.0, 16.0)),
        'dn_dt_bias': dt + jnp.log(-jnp.expm1(-dt)),
        'dn_norm_w': gain((L, DN_HEAD_DIM)),
        'mla_q_norm': gain((L, MLA_Q_RANK)),
        'mla_kv_norm': gain((L, MLA_KV_RANK)),
        'mla_w_uq': nrm((L, MLA_Q_RANK, MLA_HEADS * (MLA_NOPE + MLA_ROPE)), MLA_Q_RANK ** -0.5),
        'mla_w_ukv': nrm((L, MLA_KV_RANK, MLA_HEADS * (MLA_NOPE + MLA_V)), MLA_KV_RANK ** -0.5),
        'mla_q_qk_norm': gain((L, MLA_NOPE + MLA_ROPE)),
        'mla_k_qk_norm': gain((L, MLA_NOPE + MLA_ROPE)),
    }


def reference(x, c, ctx, c_ctx, norm_w, w_ada, b_ada, w_in, w_out, attn_q_norm, attn_k_norm,
              lru_conv_w, lru_conv_b, lru_w_a, lru_b_a, lru_w_x, lru_b_x, lru_lambda,
              dn_conv_w, dn_a_log, dn_dt_bias, dn_norm_w,
              mla_q_norm, mla_kv_norm, mla_w_uq, mla_w_ukv, mla_q_qk_norm, mla_k_qk_norm):
    n_tok = x.shape[1]
    ROWS = n_tok // GRID_W
    rows = jnp.repeat(jnp.arange(ROWS), GRID_W)
    cols = jnp.tile(jnp.arange(GRID_W), ROWS)
    for l in range(DEPTH):
        x, ctx = _layer(x, ctx, c, c_ctx, rows, cols, l < DEPTH - 1,
                        norm_w[l], w_ada[l], b_ada[l], w_in[l], w_out[l], attn_q_norm[l], attn_k_norm[l],
                        lru_conv_w[l], lru_conv_b[l], lru_w_a[l], lru_b_a[l], lru_w_x[l], lru_b_x[l],
                        lru_lambda[l], dn_conv_w[l], dn_a_log[l], dn_dt_bias[l], dn_norm_w[l],
                        mla_q_norm[l], mla_kv_norm[l], mla_w_uq[l], mla_w_ukv[l],
                        mla_q_qk_norm[l], mla_k_qk_norm[l])
    return x
```

```cpp
#include <hip/hip_runtime.h>
#include <hip/hip_cooperative_groups.h>
#include <cstdio>
namespace cg = cooperative_groups;

#ifndef MEGA
#define MEGA 1
#endif
#ifndef ONLY
#define ONLY -1
#endif
#define EN(x) (ONLY < 0 || ONLY == (x))
#ifndef REP_SUB
#define REP_SUB 0
#endif
#ifndef REP_K
#define REP_K -1
#endif
#ifndef SUB
#define SUB -1
#endif
#define ENS(x) (SUB < 0 || SUB == (x))

typedef unsigned short bf16_t;
using bf16x8 = __attribute__((ext_vector_type(8))) short;
using f32x16 = __attribute__((ext_vector_type(16))) float;
using u32x4 = __attribute__((ext_vector_type(4))) unsigned;
#define DI __device__ __forceinline__
#define NI __device__ __forceinline__
#define MFMA32(a, b, c) __builtin_amdgcn_mfma_f32_32x32x16_bf16((a), (b), (c), 0, 0, 0)

constexpr int T = 8448, NCTX = 256, DM = 2048, INW = 5840, INP = 5888, NL = 4;
constexpr int O_AQ = 0, O_AK = 512, O_AV = 768, O_AZ = 1024, O_BX = 1536, O_BZ = 2048, O_CQKV = 2560, O_CZ = 4096,
              O_CAB = 4608, O_DCQ = 4624, O_DCKV = 5008, O_DKR = 5264, O_DZ = 5328;
constexpr int LDP = 2112;
constexpr int NCH = 132;
constexpr float EPS = 1e-6f;

constexpr size_t al256(size_t x) { return (x + 255) / 256 * 256; }
constexpr size_t WS_CTR = 0;
constexpr size_t WS_BAR = 4096;
constexpr size_t WS_WTIN = 8192;
constexpr size_t WS_WTOUT = WS_WTIN + al256((size_t)NL * INP * LDP * 2);
constexpr size_t WS_WTUQ = WS_WTOUT + al256((size_t)NL * DM * LDP * 2);
constexpr size_t WS_WTUKV = WS_WTUQ + al256((size_t)NL * 768 * 384 * 2);
constexpr size_t WS_WTLRU = WS_WTUKV + al256((size_t)NL * 1024 * 256 * 2);
constexpr size_t WS_MOD = WS_WTLRU + al256((size_t)NL * 2048 * 128 * 2);
constexpr size_t WS_X = WS_MOD + al256((size_t)NL * 2 * 6144 * 4);
constexpr size_t WS_H = WS_X + al256((size_t)T * DM * 4);
constexpr size_t WS_U = WS_H + al256((size_t)T * LDP * 2);
constexpr size_t WS_AB = WS_U + al256((size_t)T * INP * 2);
constexpr size_t WS_QA = WS_AB + al256((size_t)T * 16 * 4);
constexpr size_t WS_KA = WS_QA + al256((size_t)4 * T * 128 * 2);
constexpr size_t WS_VAT = WS_KA + al256((size_t)2 * T * 128 * 2);
constexpr size_t WS_QDR = WS_VAT + al256((size_t)2 * T * 128 * 2);
constexpr size_t WS_KVDR = WS_QDR + al256((size_t)T * 768 * 2);
constexpr size_t WS_QD = WS_KVDR + al256((size_t)T * 1024 * 2);
constexpr size_t WS_KD = WS_QD + al256((size_t)4 * T * 192 * 2);
constexpr size_t WS_VDT = WS_KD + al256((size_t)4 * T * 192 * 2);
constexpr size_t WS_XL = WS_VDT + al256((size_t)4 * T * 128 * 2);
constexpr size_t WS_XLB = WS_XL + al256((size_t)T * 512 * 4);
constexpr size_t WS_G = WS_XLB + al256((size_t)T * 512 * 2);
constexpr size_t WS_HL = WS_G + al256((size_t)T * 2048 * 4);
constexpr size_t WS_CQKV = WS_HL + al256((size_t)2 * T * 512 * 4);
constexpr size_t WS_BG = WS_CQKV + al256((size_t)T * 1536 * 4);
constexpr size_t WS_DU = WS_BG + al256((size_t)T * 16 * 4);
constexpr size_t WS_DW = WS_DU + al256((size_t)8 * T * 128 * 2);
constexpr size_t WS_DQ = WS_DW + al256((size_t)8 * T * 128 * 2);
constexpr size_t WS_DKT = WS_DQ + al256((size_t)8 * T * 128 * 2);
constexpr size_t WS_DQK = WS_DKT + al256((size_t)8 * T * 128 * 2);
constexpr size_t WS_DGL = WS_DQK + al256((size_t)8 * NCH * 64 * 64 * 2);
constexpr size_t WS_DO = WS_DGL + al256((size_t)8 * NCH * 4);
constexpr size_t WS_Y = WS_DO + al256((size_t)8 * T * 128 * 4);
constexpr size_t WS_END = WS_Y + al256((size_t)T * LDP * 2);

struct P {
  const float* in[28];
  float* out;
  char* ws;
  int ph_lo, ph_hi;
};
enum { I_X = 0, I_C, I_CTX, I_CCTX, I_NORMW, I_WADA, I_BADA, I_WIN, I_WOUT, I_AQN, I_AKN, I_LCW, I_LCB, I_LWA, I_LBA, I_LWX, I_LBX,
       I_LLAM, I_DCW, I_DALOG, I_DDT, I_DNW, I_MQN, I_MKVN, I_MWUQ, I_MWUKV, I_MQQK, I_MKQK };

DI float bf2f(bf16_t b) { return __uint_as_float(((unsigned)b) << 16); }
DI bf16_t f2bf(float x) { unsigned u = __float_as_uint(x); u += 0x7fffu + ((u >> 16) & 1u); return (bf16_t)(u >> 16); }
DI unsigned pk2(float lo, float hi) { return (unsigned)f2bf(lo) | ((unsigned)f2bf(hi) << 16); }
DI float siluf(float x) { return x / (1.f + __expf(-x)); }
DI float sigm(float x) { return 1.f / (1.f + __expf(-x)); }
DI float softplusf(float x) { return x > 20.f ? x : log1pf(expf(x)); }
DI size_t tiled_off(int row, int col) { return ((size_t)((row >> 7) * 32 + (col >> 6)) << 13) + (row & 127) * 64 + (col & 63); }
DI int crow(int reg, int h) { return (reg & 3) + 8 * (reg >> 2) + 4 * h; }
DI int permkey(int t) { return (t & ~0xC) | ((t & 4) << 1) | ((t & 8) >> 1); }
DI int pos2row(int dir, int p) { return dir == 0 ? p : (p < NCTX ? NCTX - 1 - p : (T + NCTX - 1) - p); }
DI float hw_sum(float v) {
  v += __shfl_xor(v, 16); v += __shfl_xor(v, 8); v += __shfl_xor(v, 4); v += __shfl_xor(v, 2); v += __shfl_xor(v, 1); return v;
}
DI void sincos_rev(float ang, float& s, float& c) {
  float rev = ang * 0.15915494309189535f; rev -= rintf(rev);
  s = __builtin_amdgcn_sinf(rev); c = __builtin_amdgcn_cosf(rev);
}
DI unsigned cvtpk(float lo, float hi) { unsigned r; asm volatile("v_cvt_pk_bf16_f32 %0, %1, %2" : "=v"(r) : "v"(lo), "v"(hi)); return r; }
DI bf16x8 pack8(const f32x16& x, int s) {
  union { unsigned u[4]; bf16x8 v; } t;
  t.u[0] = cvtpk(x[8 * s + 0], x[8 * s + 1]); t.u[1] = cvtpk(x[8 * s + 2], x[8 * s + 3]);
  t.u[2] = cvtpk(x[8 * s + 4], x[8 * s + 5]); t.u[3] = cvtpk(x[8 * s + 6], x[8 * s + 7]);
  return t.v;
}
DI int get_tid() { int t = threadIdx.x; asm volatile("" : "+v"(t)); return t; }
DI int xcc_id() { return (int)(__builtin_amdgcn_s_getreg((3 << 11) | 20) & 7u); }
DI void grid_barrier(unsigned* bar, unsigned k, unsigned myx, unsigned n_x, unsigned nxcd) {
  __syncthreads();
  if (threadIdx.x == 0) {
    unsigned* cx = bar + 32 * myx; unsigned* l2 = bar + 32 * 16; unsigned* flag = bar + 32 * 17;
    const unsigned a = __hip_atomic_fetch_add(cx, 1u, __ATOMIC_RELAXED, __HIP_MEMORY_SCOPE_AGENT);
    if (a + 1 == k * n_x) {
      __builtin_amdgcn_fence(__ATOMIC_RELEASE, "agent");
      const unsigned b = __hip_atomic_fetch_add(l2, 1u, __ATOMIC_RELAXED, __HIP_MEMORY_SCOPE_AGENT);
      if (b + 1 == k * nxcd) __hip_atomic_store(flag, k, __ATOMIC_RELAXED, __HIP_MEMORY_SCOPE_AGENT);
    }
    while (__hip_atomic_load(flag, __ATOMIC_RELAXED, __HIP_MEMORY_SCOPE_AGENT) < k) __builtin_amdgcn_s_sleep(4);
    __builtin_amdgcn_fence(__ATOMIC_ACQUIRE, "agent");
  }
  __syncthreads();
}
DI int next_item(unsigned* ctr, int* s_item) {
  __syncthreads();
  if (threadIdx.x == 0) *s_item = (int)atomicAdd(ctr, 1u);
  __syncthreads();
  return *s_item;
}

DI bool xcd_tile(int g, int i, int MT, int NT, int& m, int& n) {
  const int idx = (((i >> 6) * 8 + g) << 6) + (i & 63);
  if (idx >= MT * NT) return false;
  const int full = NT >> 3, wr = NT & 7, fp = full * MT * 8;
  if (idx < fp) { const int pnl = idx / (MT * 8), rem = idx % (MT * 8); m = rem >> 3; n = pnl * 8 + (rem & 7); }
  else { const int rem = idx - fp; m = rem / wr; n = full * 8 + rem % wr; }
  return true;
}
#define ITEMS_STATIC(item, total) for (int item = (__syncthreads(), (int)blockIdx.x); item < (total); item = (__syncthreads(), item + (int)gridDim.x))
struct Epi {
  bf16_t* cb; int ldc;
  float* cf;
  const float* bias0; const float* bias1;
  const float* xin_lat; const float* xin_ctx;
  float* xout; float* out;
  const float* gate_lat; const float* gate_ctx;
  int last;
  const float* lam; const float* xl; float* la; float* lb;
};
template <int EPI>
DI void epi_store(const Epi& e, int row, int col, float v) {
  if constexpr (EPI == 0) {
    e.cb[(size_t)row * INP + col] = f2bf(v);
    if (col >= O_CAB && col < O_CAB + 16) e.cf[row * 16 + (col - O_CAB)] = v;
  } else if constexpr (EPI == 1) {
    e.cb[(size_t)row * e.ldc + col] = f2bf(v);
  } else if constexpr (EPI == 2) {
  } else {
    float xo, g;
    if (row < NCTX) { xo = e.xin_ctx[(size_t)row * DM + col]; g = e.gate_ctx[col]; }
    else { xo = e.xin_lat[(size_t)(row - NCTX) * DM + col]; g = e.gate_lat[col]; }
    float xn = xo + g * v;
    if (e.last) { if (row >= NCTX) e.out[(size_t)(row - NCTX) * DM + col] = xn; }
    else e.xout[(size_t)row * DM + col] = xn;
  }
}
template <int EPI, bool TILED = false>
NI void gemm_tile(const bf16_t* __restrict__ A, int lda, const bf16_t* __restrict__ Bt, int ldb, int K, int m0, int n0, char* lds, const Epi& ep) {
  char* As = lds; char* Bs = lds + 36864;
  const int tid = get_tid(), w = tid >> 6, lane = tid & 63, r = lane & 31, h = lane >> 5, wm = w >> 1, wn = w & 1;
  f32x16 acc[2][2];
#pragma unroll
  for (int i = 0; i < 2; ++i)
#pragma unroll
    for (int j = 0; j < 2; ++j)
#pragma unroll
      for (int q = 0; q < 16; ++q) acc[i][j][q] = 0.f;
  u32x4 ar0[4], br0[4], ar1[4], br1[4];
  const int srow = tid >> 3, sch = tid & 7;
  const bf16_t* Ag = TILED ? A + ((size_t)(m0 >> 7) * 32 << 13) + srow * 64 + sch * 8 : A + (size_t)(m0 + srow) * lda + sch * 8;
  const bf16_t* Bg = TILED ? Bt + ((size_t)(n0 >> 7) * 32 << 13) + srow * 64 + sch * 8 : Bt + (size_t)(n0 + srow) * ldb + sch * 8;
  const size_t a_rs = TILED ? 64 : lda, b_rs = TILED ? 64 : ldb, k_st = TILED ? 8192 : 64;
  const int KT = K >> 6;
#define G_LOAD(S, kt) do { _Pragma("unroll") for (int i = 0; i < 4; ++i) { \
      ar##S[i] = *(const u32x4*)(Ag + (size_t)(32 * i) * a_rs + (size_t)(kt) * k_st); br##S[i] = *(const u32x4*)(Bg + (size_t)(32 * i) * b_rs + (size_t)(kt) * k_st); } } while (0)
#define G_STORE(S, buf) do { _Pragma("unroll") for (int i = 0; i < 4; ++i) { int off = (srow + 32 * i) * 144 + sch * 16; \
      *(u32x4*)(As + (buf) * 18432 + off) = ar##S[i]; *(u32x4*)(Bs + (buf) * 18432 + off) = br##S[i]; } } while (0)
#define G_COMPUTE(buf) do { \
    const char* Ab = As + (buf) * 18432 + (wm * 64 + r) * 144 + h * 16; const char* Bb = Bs + (buf) * 18432 + (wn * 64 + r) * 144 + h * 16; \
    _Pragma("unroll") for (int ks = 0; ks < 4; ++ks) { \
      bf16x8 a[2], b[2]; \
      _Pragma("unroll") for (int i = 0; i < 2; ++i) a[i] = *(const bf16x8*)(Ab + i * 32 * 144 + ks * 32); \
      _Pragma("unroll") for (int j = 0; j < 2; ++j) b[j] = *(const bf16x8*)(Bb + j * 32 * 144 + ks * 32); \
      _Pragma("unroll") for (int i = 0; i < 2; ++i) \
        _Pragma("unroll") for (int j = 0; j < 2; ++j) acc[i][j] = MFMA32(a[i], b[j], acc[i][j]); \
    } } while (0)
  G_LOAD(0, 0); G_LOAD(1, 1); G_STORE(0, 0); __syncthreads();
  for (int kt = 0; kt < KT; kt += 2) {
    G_LOAD(0, (kt + 2 < KT) ? kt + 2 : 0);
    G_COMPUTE(0);
    G_STORE(1, 1);
    __syncthreads();
    G_LOAD(1, (kt + 3 < KT) ? kt + 3 : 1);
    G_COMPUTE(1);
    if (kt + 2 < KT) G_STORE(0, 0);
    __syncthreads();
  }
#undef G_COMPUTE
#undef G_LOAD
#undef G_STORE
  if constexpr (EPI == 2) {
    const int nt = n0 >> 7, dir = nt >> 3, ch = ((nt >> 1) & 3) * 128 + (nt & 1) * 64 + wn * 32 + r;
    const float ba = ep.bias0[dir * 512 + ch], bx = ep.bias1[dir * 512 + ch];
    const float sp = softplusf(-ep.lam[dir * 512 + ch]);
    float* la = ep.la + (size_t)dir * T * 512 + ch; float* lb = ep.lb + (size_t)dir * T * 512 + ch;
    float xlv[2][16];
#pragma unroll
    for (int i = 0; i < 2; ++i)
#pragma unroll
      for (int q = 0; q < 16; ++q) xlv[i][q] = ep.xl[(size_t)(m0 + wm * 64 + i * 32 + crow(q, h)) * 512 + ch];
#pragma unroll
    for (int i = 0; i < 2; ++i)
#pragma unroll
      for (int q = 0; q < 16; ++q) {
        const int row = m0 + wm * 64 + i * 32 + crow(q, h);
        const float rg = sigm(acc[i][0][q] + ba), ig = sigm(acc[i][1][q] + bx), xv = xlv[i][q];
        const float lg = -8.f * rg * sp;
        la[(size_t)row * 512] = expf(lg);
        lb[(size_t)row * 512] = sqrtf(-expm1f(2.f * lg)) * (ig * xv);
      }
  } else if constexpr (EPI == 3) {
    const bool isctx = m0 < NCTX;
    const float* xin = isctx ? ep.xin_ctx + (size_t)m0 * DM : ep.xin_lat + (size_t)(m0 - NCTX) * DM;
    const int colb = n0 + wn * 64 + r;
    float gt[2], xo[2][2][16];
#pragma unroll
    for (int j = 0; j < 2; ++j) gt[j] = (isctx ? ep.gate_ctx : ep.gate_lat)[colb + j * 32];
#pragma unroll
    for (int i = 0; i < 2; ++i)
#pragma unroll
      for (int j = 0; j < 2; ++j)
#pragma unroll
        for (int q = 0; q < 16; ++q) xo[i][j][q] = xin[(size_t)(wm * 64 + i * 32 + crow(q, h)) * DM + colb + j * 32];
    if (!(ep.last && isctx)) {
      float* dst = ep.last ? ep.out + (size_t)(m0 - NCTX) * DM : ep.xout + (size_t)m0 * DM;
#pragma unroll
      for (int i = 0; i < 2; ++i)
#pragma unroll
        for (int j = 0; j < 2; ++j)
#pragma unroll
          for (int q = 0; q < 16; ++q) dst[(size_t)(wm * 64 + i * 32 + crow(q, h)) * DM + colb + j * 32] = xo[i][j][q] + gt[j] * acc[i][j][q];
    }
  } else {
#pragma unroll
  for (int i = 0; i < 2; ++i)
#pragma unroll
    for (int j = 0; j < 2; ++j)
#pragma unroll
      for (int q = 0; q < 16; ++q)
        epi_store<EPI>(ep, m0 + wm * 64 + i * 32 + crow(q, h), n0 + wn * 64 + j * 32 + r, acc[i][j][q]);
  }
}

template <int DQK>
NI void attn_item(const bf16_t* __restrict__ Q, const bf16_t* __restrict__ Kp, const bf16_t* __restrict__ VT, int q0, int ntiles,
                  const bf16_t* __restrict__ Z, bf16_t* __restrict__ Yb, int ycol, float scale_log2, char* lds) {
  constexpr int KS = DQK / 16, CPR = DQK / 8, KROW = DQK * 2 + 16, NKC = CPR / 4;
  char* Ks = lds; char* Vs = lds + 64 * KROW;
  const int tid = get_tid(), w = tid >> 6, lane = tid & 63, r = lane & 31, h = lane >> 5;
  bf16x8 qr[KS];
  const bf16_t* qp = Q + (size_t)(q0 + w * 32 + r) * DQK + h * 8;
#pragma unroll
  for (int ks = 0; ks < KS; ++ks) qr[ks] = *(const bf16x8*)(qp + ks * 16);
  f32x16 ot[4];
#pragma unroll
  for (int n = 0; n < 4; ++n)
#pragma unroll
    for (int q = 0; q < 16; ++q) ot[n][q] = 0.f;
  float m = -1e30f, lsum = 0.f;
  u32x4 kreg[NKC], vreg[4];
  const int krow_s = tid >> 2, kcq = tid & 3, vrow_s = tid >> 3, vch = tid & 7;
  const bf16_t* Kg = Kp + (size_t)krow_s * DQK + kcq * 8;
  const bf16_t* Vg = VT + tid * 8;
  char* Kst = Ks + krow_s * KROW + kcq * 16;
  char* Vst = Vs + vrow_s * 144 + vch * 16;
#define A_LOAD(tile) do { _Pragma("unroll") for (int i = 0; i < NKC; ++i) kreg[i] = *(const u32x4*)(Kg + (size_t)(tile) * 64 * DQK + i * 32); \
    _Pragma("unroll") for (int i = 0; i < 4; ++i) vreg[i] = *(const u32x4*)(Vg + (size_t)(tile) * 8192 + i * 2048); } while (0)
#define A_STORE() do { _Pragma("unroll") for (int i = 0; i < NKC; ++i) *(u32x4*)(Kst + i * 64) = kreg[i]; \
    _Pragma("unroll") for (int i = 0; i < 4; ++i) *(u32x4*)(Vst + i * 32 * 144) = vreg[i]; } while (0)
  const char* Krd = Ks + r * KROW + h * 16;
  const char* Vrd = Vs + r * 144 + h * 16;
  A_LOAD(0);
  for (int t = 0; t < ntiles; ++t) {
    __syncthreads();
    A_STORE();
    __syncthreads();
    if (t + 1 < ntiles) A_LOAD(t + 1);
    f32x16 st0, st1;
#pragma unroll
    for (int q = 0; q < 16; ++q) { st0[q] = 0.f; st1[q] = 0.f; }
#pragma unroll
    for (int ks = 0; ks < KS; ++ks) {
      bf16x8 a0 = *(const bf16x8*)(Krd + ks * 32);
      bf16x8 a1 = *(const bf16x8*)(Krd + 32 * KROW + ks * 32);
      st0 = MFMA32(a0, qr[ks], st0);
      st1 = MFMA32(a1, qr[ks], st1);
    }
    float mx = st0[0];
#pragma unroll
    for (int q = 1; q < 16; ++q) mx = fmaxf(mx, st0[q]);
#pragma unroll
    for (int q = 0; q < 16; ++q) mx = fmaxf(mx, st1[q]);
    mx = fmaxf(mx, __shfl_xor(mx, 32));
    const float mnew = fmaxf(m, mx * scale_log2);
    const float alpha = __builtin_amdgcn_exp2f(m - mnew);
    m = mnew;
    float ps = 0.f;
#pragma unroll
    for (int q = 0; q < 16; ++q) { st0[q] = __builtin_amdgcn_exp2f(st0[q] * scale_log2 - mnew); ps += st0[q]; }
#pragma unroll
    for (int q = 0; q < 16; ++q) { st1[q] = __builtin_amdgcn_exp2f(st1[q] * scale_log2 - mnew); ps += st1[q]; }
    lsum = lsum * alpha + ps;
    if (!__all(alpha == 1.f)) {
#pragma unroll
      for (int n = 0; n < 4; ++n)
#pragma unroll
        for (int q = 0; q < 16; ++q) ot[n][q] *= alpha;
    }
    bf16x8 pf[4];
    pf[0] = pack8(st0, 0); pf[1] = pack8(st0, 1); pf[2] = pack8(st1, 0); pf[3] = pack8(st1, 1);
#pragma unroll
    for (int n = 0; n < 4; ++n) {
#pragma unroll
      for (int ks = 0; ks < 4; ++ks) {
        bf16x8 a = *(const bf16x8*)(Vrd + n * 32 * 144 + ks * 32);
        ot[n] = MFMA32(a, pf[ks], ot[n]);
      }
    }
  }
#undef A_LOAD
#undef A_STORE
  lsum += __shfl_xor(lsum, 32);
  const float inv = 1.f / lsum;
  const int row = q0 + w * 32 + r;
  uint2 zq[4][4];
#pragma unroll
  for (int n = 0; n < 4; ++n)
#pragma unroll
    for (int g = 0; g < 4; ++g) zq[n][g] = *(const uint2*)(Z + (size_t)row * INP + n * 32 + 8 * g + 4 * h);
#pragma unroll
  for (int n = 0; n < 4; ++n)
#pragma unroll
    for (int g = 0; g < 4; ++g) {
      const int e0 = n * 32 + 8 * g + 4 * h;
      const uint2 zz = zq[n][g];
      float z0 = __uint_as_float(zz.x << 16), z1 = __uint_as_float(zz.x & 0xffff0000u), z2 = __uint_as_float(zz.y << 16), z3 = __uint_as_float(zz.y & 0xffff0000u);
      uint2 o;
      o.x = pk2(ot[n][4 * g + 0] * inv * siluf(z0), ot[n][4 * g + 1] * inv * siluf(z1));
      o.y = pk2(ot[n][4 * g + 2] * inv * siluf(z2), ot[n][4 * g + 3] * inv * siluf(z3));
      *(uint2*)(Yb + tiled_off(row, ycol + e0)) = o;
    }
}

DI void transpose_tile(const float* __restrict__ src, int K, int N, bf16_t* __restrict__ dst, const float* __restrict__ kscale, int k0, int n0, char* lds, int rm_gate = -1, int ldd = 0) {
  const bool tiled = ldd < 0;
  if (ldd == 0) ldd = K;
  float* tile = (float*)lds;
  const int tid = get_tid();
  {
    const int nn = tid & 127, kq = tid >> 7;
    const bool ok = n0 + nn < N;
    float v[32];
#pragma unroll
    for (int i = 0; i < 32; ++i) v[i] = ok ? src[(size_t)(k0 + kq + 2 * i) * N + n0 + nn] : 0.f;
    if (kscale) {
#pragma unroll
      for (int i = 0; i < 32; ++i) v[i] *= kscale[k0 + kq + 2 * i];
    }
#pragma unroll
    for (int i = 0; i < 32; ++i) tile[(kq + 2 * i) * 129 + nn] = v[i];
  }
  __syncthreads();
  {
    const int nn = tid >> 1, kg = tid & 1;
    unsigned o[16];
#pragma unroll
    for (int i = 0; i < 16; ++i) o[i] = pk2(tile[(kg * 32 + 2 * i) * 129 + nn], tile[(kg * 32 + 2 * i + 1) * 129 + nn]);
    const int drow = rm_gate < 0 ? n0 + nn : ((nn >> 6) * 128 + ((nn >> 5) & 1) * 64 + rm_gate * 32 + (nn & 31));
    uint4* d = (uint4*)(tiled ? dst + tiled_off(drow, k0 + kg * 32) : dst + (size_t)drow * ldd + k0 + kg * 32);
#pragma unroll
    for (int i = 0; i < 4; ++i) d[i] = make_uint4(o[4 * i], o[4 * i + 1], o[4 * i + 2], o[4 * i + 3]);
  }
}

NI void phase0(const P& p, unsigned* ctr, int* s_item, char* lds) {
  char* ws = p.ws;
  constexpr int J_IN = 32 * 46, J_OUT = 32 * 16, J_UQ = 6 * 6, J_UKV = 4 * 8, J_LRU = 32;
  constexpr int J_L = J_IN + J_OUT + J_UQ + J_UKV + J_LRU;
  constexpr int N_TR = NL * J_L, N_GEMV = NL * 96;
  ITEMS_STATIC(item, N_GEMV + N_TR) {
    if (item < N_GEMV) {
      const int l = item / 96, nc = item % 96;
      float* sc = (float*)lds;
      for (int k = get_tid(); k < 2048; k += 256) { sc[k] = siluf(p.in[I_C][k]); sc[2048 + k] = siluf(p.in[I_CCTX][k]); }
      __syncthreads();
      const int nl = get_tid() & 63, kq = get_tid() >> 6, n = nc * 64 + nl;
      const float* wp = p.in[I_WADA] + (size_t)l * 2048 * 6144 + n;
      float a0 = 0.f, a1 = 0.f;
      for (int kb = 0; kb < 512; kb += 32) {
        float wv[32];
#pragma unroll
        for (int u = 0; u < 32; ++u) wv[u] = wp[(size_t)(kq + 4 * (kb + u)) * 6144];
#pragma unroll
        for (int u = 0; u < 32; ++u) { const int k = kq + 4 * (kb + u); a0 += sc[k] * wv[u]; a1 += sc[2048 + k] * wv[u]; }
      }
      float* red = (float*)(lds + 16384);
      red[kq * 64 + nl] = a0; red[256 + kq * 64 + nl] = a1;
      __syncthreads();
      if (kq == 0) {
        float b = p.in[I_BADA][l * 6144 + n];
        float* mod = (float*)(ws + WS_MOD) + (size_t)l * 2 * 6144;
        mod[n] = red[nl] + red[64 + nl] + red[128 + nl] + red[192 + nl] + b;
        mod[6144 + n] = red[256 + nl] + red[320 + nl] + red[384 + nl] + red[448 + nl] + b;
      }
    } else {
      int j = item - N_GEMV; const int l = j / J_L; j %= J_L;
      if (j < J_IN) {
        transpose_tile(p.in[I_WIN] + (size_t)l * DM * INW, DM, INW, (bf16_t*)(ws + WS_WTIN) + (size_t)l * INP * LDP, nullptr, (j / 46) * 64, (j % 46) * 128, lds, -1, -1);
      } else if ((j -= J_IN) < J_OUT) {
        transpose_tile(p.in[I_WOUT] + (size_t)l * DM * DM, DM, DM, (bf16_t*)(ws + WS_WTOUT) + (size_t)l * DM * LDP, nullptr, (j / 16) * 64, (j % 16) * 128, lds, -1, -1);
      } else if ((j -= J_OUT) < J_UQ) {
        transpose_tile(p.in[I_MWUQ] + (size_t)l * 384 * 768, 384, 768, (bf16_t*)(ws + WS_WTUQ) + (size_t)l * 768 * 384, p.in[I_MQN] + l * 384, (j / 6) * 64, (j % 6) * 128, lds);
      } else if ((j -= J_UQ) < J_UKV) {
        transpose_tile(p.in[I_MWUKV] + (size_t)l * 256 * 1024, 256, 1024, (bf16_t*)(ws + WS_WTUKV) + (size_t)l * 1024 * 256, p.in[I_MKVN] + l * 256, (j / 8) * 64, (j % 8) * 128, lds);
      } else {
        j -= J_UKV;
        const int mat = j >> 1, tl = j & 1, dir = mat >> 3, gate = (mat >> 2) & 1, blk = mat & 3;
        const float* src = (gate ? p.in[I_LWX] : p.in[I_LWA]) + ((size_t)(l * 2 + dir) * 4 + blk) * 128 * 128;
        bf16_t* dst = (bf16_t*)(ws + WS_WTLRU) + ((size_t)l * 2048 + (dir * 8 + blk * 2) * 128) * 128;
        transpose_tile(src, 128, 128, dst, nullptr, tl * 64, 0, lds, gate);
      }
    }
  }
}

DI const float* xrow_ptr(const P& p, int layer, int t) {
  if (layer == 0) return t < NCTX ? p.in[I_CTX] + (size_t)t * DM : p.in[I_X] + (size_t)(t - NCTX) * DM;
  return (const float*)(p.ws + WS_X) + (size_t)t * DM;
}
NI void phase_norm(const P& p, int l, unsigned* ctr, int* s_item, char* lds) {
  const float* nw = p.in[I_NORMW] + l * DM;
  const float* mod = (const float*)(p.ws + WS_MOD) + (size_t)l * 2 * 6144;
  bf16_t* H = (bf16_t*)(p.ws + WS_H);
  float* red = (float*)lds;
  const int tid = get_tid();
  ITEMS_STATIC(item, T / 4) {
    const int t0 = item * 4;
    float4 v0[4], v1[4];
#pragma unroll
    for (int rr = 0; rr < 4; ++rr) {
      const float* xp = xrow_ptr(p, l, t0 + rr) + tid * 8;
      v0[rr] = *(const float4*)xp; v1[rr] = *(const float4*)(xp + 4);
    }
    const float* md = mod + (t0 < NCTX ? 6144 : 0);
    float wv[8], sc[8], sh[8];
#pragma unroll
    for (int i = 0; i < 8; ++i) { const int c0 = tid * 8 + i; wv[i] = nw[c0]; sc[i] = 1.f + md[2048 + c0]; sh[i] = md[c0]; }
#pragma unroll
    for (int rr = 0; rr < 4; ++rr) {
      float ss = v0[rr].x * v0[rr].x + v0[rr].y * v0[rr].y + v0[rr].z * v0[rr].z + v0[rr].w * v0[rr].w +
                 v1[rr].x * v1[rr].x + v1[rr].y * v1[rr].y + v1[rr].z * v1[rr].z + v1[rr].w * v1[rr].w;
      ss += __shfl_xor(ss, 32); ss = hw_sum(ss);
      if ((tid & 63) == 0) red[rr * 4 + (tid >> 6)] = ss;
    }
    __syncthreads();
#pragma unroll
    for (int rr = 0; rr < 4; ++rr) {
      const float ss = red[rr * 4] + red[rr * 4 + 1] + red[rr * 4 + 2] + red[rr * 4 + 3];
      const float rstd = rsqrtf(ss * (1.f / DM) + EPS);
      const float xv[8] = {v0[rr].x, v0[rr].y, v0[rr].z, v0[rr].w, v1[rr].x, v1[rr].y, v1[rr].z, v1[rr].w};
      unsigned o[4];
#pragma unroll
      for (int i = 0; i < 4; ++i)
        o[i] = pk2(xv[2 * i] * rstd * wv[2 * i] * sc[2 * i] + sh[2 * i], xv[2 * i + 1] * rstd * wv[2 * i + 1] * sc[2 * i + 1] + sh[2 * i + 1]);
      *(uint4*)(H + tiled_off(t0 + rr, tid * 8)) = make_uint4(o[0], o[1], o[2], o[3]);
    }
  }
}

constexpr int RB = 4;
NI void prepA_row(const P& p, int l, int t0) {
  char* ws = p.ws;
  const bf16_t* __restrict__ U = (const bf16_t*)(ws + WS_U);
  const int tid = get_tid(), hw = tid >> 5, ln = tid & 31;
  const bool lat = t0 >= NCTX;
  const int seg_lo = lat ? NCTX : 0, seg_hi = lat ? T : NCTX;
  for (int task = hw; task < 25; task += 8) {
    if (task < 6) {
      const bool isq = task < 4; const int hd = isq ? task : task - 4;
      const bf16_t* src = U + (size_t)t0 * INP + (isq ? O_AQ : O_AK) + hd * 128 + ln;
      const float* nwp = (isq ? p.in[I_AQN] : p.in[I_AKN]) + l * 128 + ln;
      float x[RB][4], nw[4];
#pragma unroll
      for (int rr = 0; rr < RB; ++rr)
#pragma unroll
        for (int j = 0; j < 4; ++j) x[rr][j] = bf2f(src[(size_t)rr * INP + 32 * j]);
#pragma unroll
      for (int j = 0; j < 4; ++j) nw[j] = nwp[32 * j];
      const float invf = exp2f(-(float)ln * (13.287712379549449f / 32.f));
      bf16_t* dst = (bf16_t*)(ws + (isq ? WS_QA : WS_KA)) + ((size_t)hd * T + t0) * 128 + ln;
#pragma unroll
      for (int rr = 0; rr < RB; ++rr) {
        float ss = x[rr][0] * x[rr][0] + x[rr][1] * x[rr][1] + x[rr][2] * x[rr][2] + x[rr][3] * x[rr][3];
        ss = hw_sum(ss);
        const float rstd = rsqrtf(ss * (1.f / 128.f) + EPS);
#pragma unroll
        for (int j = 0; j < 4; ++j) x[rr][j] = x[rr][j] * rstd * nw[j];
        if (lat) {
          const int tt = t0 + rr - NCTX, rpos = tt >> 6, cpos = tt & 63;
          float sn, c;
          sincos_rev((float)rpos * invf, sn, c);
          float a = x[rr][0] * c - x[rr][1] * sn, b = x[rr][0] * sn + x[rr][1] * c; x[rr][0] = a; x[rr][1] = b;
          sincos_rev((float)cpos * invf, sn, c);
          a = x[rr][2] * c - x[rr][3] * sn; b = x[rr][2] * sn + x[rr][3] * c; x[rr][2] = a; x[rr][3] = b;
        }
#pragma unroll
        for (int j = 0; j < 4; ++j) dst[rr * 128 + 32 * j] = f2bf(x[rr][j]);
      }
    } else if (task < 8) {
      const int hd = task - 6;
      const bf16_t* src = U + (size_t)t0 * INP + O_AV + hd * 128 + ln;
      bf16_t v[RB][4];
#pragma unroll
      for (int rr = 0; rr < RB; ++rr)
#pragma unroll
        for (int j = 0; j < 4; ++j) v[rr][j] = src[(size_t)rr * INP + 32 * j];
#pragma unroll
      for (int rr = 0; rr < RB; ++rr) {
        const int t = t0 + rr;
        bf16_t* dst = (bf16_t*)(ws + WS_VAT) + (size_t)hd * 128 * T + (size_t)(t >> 6) * 8192 + (permkey(t) & 63);
#pragma unroll
        for (int j = 0; j < 4; ++j) dst[(ln + 32 * j) * 64] = v[rr][j];
      }
    } else if (task < 24) {
      const bool islru = task < 12;
      const int sg = islru ? task - 8 : task - 12;
      const int cbase = sg * 128 + ln, ucol = (islru ? O_BX : O_CQKV) + cbase, cwn = islru ? 512 : 1536;
      const float* cw = (islru ? p.in[I_LCW] + (size_t)l * 4 * 512 : p.in[I_DCW] + (size_t)l * 4 * 1536) + cbase;
      float u[RB + 3][4], w[4][4];
#pragma unroll
      for (int i = 0; i < RB + 3; ++i) {
        const int rrow = t0 - 2 + i; const bool ok = rrow >= seg_lo && rrow < seg_hi;
#pragma unroll
        for (int j = 0; j < 4; ++j) u[i][j] = ok ? bf2f(U[(size_t)rrow * INP + ucol + 32 * j]) : 0.f;
      }
#pragma unroll
      for (int tap = 0; tap < 4; ++tap)
#pragma unroll
        for (int j = 0; j < 4; ++j) w[tap][j] = cw[tap * cwn + 32 * j];
      if (islru) {
        float cb[4];
#pragma unroll
        for (int j = 0; j < 4; ++j) cb[j] = p.in[I_LCB][l * 512 + cbase + 32 * j];
#pragma unroll
        for (int rr = 0; rr < RB; ++rr)
#pragma unroll
          for (int j = 0; j < 4; ++j) {
            float acc = cb[j];
#pragma unroll
            for (int tap = 0; tap < 4; ++tap) acc += w[tap][j] * u[rr + tap][j];
            const size_t o = (size_t)(t0 + rr) * 512 + cbase + 32 * j;
            ((float*)(ws + WS_XL))[o] = acc;
            ((bf16_t*)(ws + WS_XLB))[o] = f2bf(acc);
          }
      } else {
#pragma unroll
        for (int rr = 0; rr < RB; ++rr) {
          float x[4]; float ss = 0.f;
#pragma unroll
          for (int j = 0; j < 4; ++j) {
            float acc = 0.f;
#pragma unroll
            for (int tap = 0; tap < 4; ++tap) acc += w[tap][j] * u[rr + tap][j];
            x[j] = siluf(acc); ss += x[j] * x[j];
          }
          if (sg < 8) {
            ss = hw_sum(ss);
            float sc = rsqrtf(ss + EPS); if (sg < 4) sc *= 0.08838834764831845f;
#pragma unroll
            for (int j = 0; j < 4; ++j) x[j] *= sc;
          }
#pragma unroll
          for (int j = 0; j < 4; ++j) ((float*)(ws + WS_CQKV))[(size_t)(t0 + rr) * 1536 + cbase + 32 * j] = x[j];
        }
      }
    } else {
      const int rr = ln >> 3, dir = (ln >> 2) & 1, hd = ln & 3, t = t0 + rr;
      const float* ab = (const float*)(ws + WS_AB) + (size_t)t * 16 + dir * 8;
      const float beta = 1.f / (1.f + expf(-ab[hd]));
      const float g = -expf(p.in[I_DALOG][l * 8 + dir * 4 + hd]) * softplusf(ab[4 + hd] + p.in[I_DDT][l * 8 + dir * 4 + hd]);
      float* bg = (float*)(ws + WS_BG) + (size_t)t * 16 + dir * 8;
      bg[hd] = beta; bg[4 + hd] = g;
    }
  }
}

constexpr int RBD = 2;
NI void prepD_row(const P& p, int l, int t0) {
  char* ws = p.ws;
  const bf16_t* __restrict__ U = (const bf16_t*)(ws + WS_U);
  const int tid = get_tid(), hw = tid >> 5, ln = tid & 31;
  const bool lat = t0 >= NCTX;
  for (int task = hw; task < 12; task += 8) {
    const int hd = task & 3;
    const bool isq = task < 4;
    float ssi[RBD];
    if (isq) {
#pragma unroll
      for (int rr = 0; rr < RBD; ++rr) { float a = 0.f;
#pragma unroll
        for (int j = 0; j < 12; ++j) { const float v = bf2f(U[(size_t)(t0 + rr) * INP + O_DCQ + ln + 32 * j]); a += v * v; }
        ssi[rr] = a; }
    } else {
#pragma unroll
      for (int rr = 0; rr < RBD; ++rr) { float a = 0.f;
#pragma unroll
        for (int j = 0; j < 8; ++j) { const float v = bf2f(U[(size_t)(t0 + rr) * INP + O_DCKV + ln + 32 * j]); a += v * v; }
        ssi[rr] = a; }
    }
    float x[RBD][6];
    if (task < 8) {
      if (isq) {
        const bf16_t* src = (const bf16_t*)(ws + WS_QDR) + (size_t)t0 * 768 + hd * 192 + ln;
#pragma unroll
        for (int rr = 0; rr < RBD; ++rr)
#pragma unroll
          for (int j = 0; j < 6; ++j) x[rr][j] = bf2f(src[(size_t)rr * 768 + 32 * j]);
      } else {
        const bf16_t* src = (const bf16_t*)(ws + WS_KVDR) + (size_t)t0 * 1024 + hd * 256 + ln;
#pragma unroll
        for (int rr = 0; rr < RBD; ++rr) {
#pragma unroll
          for (int j = 0; j < 4; ++j) x[rr][j] = bf2f(src[(size_t)rr * 1024 + 32 * j]);
          x[rr][4] = bf2f(U[(size_t)(t0 + rr) * INP + O_DKR + ln]); x[rr][5] = bf2f(U[(size_t)(t0 + rr) * INP + O_DKR + 32 + ln]);
        }
      }
    } else {
      const bf16_t* src = (const bf16_t*)(ws + WS_KVDR) + (size_t)t0 * 1024 + hd * 256 + 128 + ln;
#pragma unroll
      for (int rr = 0; rr < RBD; ++rr) {
#pragma unroll
        for (int j = 0; j < 4; ++j) x[rr][j] = bf2f(src[(size_t)rr * 1024 + 32 * j]);
        x[rr][4] = 0.f; x[rr][5] = 0.f;
      }
    }
    float nwv[6];
    const float* nwp = (isq ? p.in[I_MQQK] : p.in[I_MKQK]) + l * 192 + ln;
#pragma unroll
    for (int j = 0; j < 6; ++j) nwv[j] = nwp[32 * j];
    const float invf = exp2f(-(float)(ln & 15) * (13.287712379549449f / 16.f));
#pragma unroll
    for (int rr = 0; rr < RBD; ++rr) {
      const int t = t0 + rr;
      const float rstd_in = rsqrtf(hw_sum(ssi[rr]) * (isq ? (1.f / 384.f) : (1.f / 256.f)) + EPS);
      if (task < 8) {
        const int nsc = isq ? 6 : 4;
#pragma unroll
        for (int j = 0; j < 6; ++j) if (j < nsc) x[rr][j] *= rstd_in;
        float ss = 0.f;
#pragma unroll
        for (int j = 0; j < 6; ++j) ss += x[rr][j] * x[rr][j];
        const float rstd = rsqrtf(hw_sum(ss) * (1.f / 192.f) + EPS);
#pragma unroll
        for (int j = 0; j < 6; ++j) x[rr][j] = x[rr][j] * rstd * nwv[j];
        if (lat) {
          const int tt = t - NCTX, rpos = tt >> 6, cpos = tt & 63;
          float sn, c;
          {
            sincos_rev((float)rpos * invf, sn, c);
            const float other = __shfl_xor(x[rr][4], 16);
            x[rr][4] = (ln < 16) ? (x[rr][4] * c - other * sn) : (other * sn + x[rr][4] * c);
          }
          {
            sincos_rev((float)cpos * invf, sn, c);
            const float other = __shfl_xor(x[rr][5], 16);
            x[rr][5] = (ln < 16) ? (x[rr][5] * c - other * sn) : (other * sn + x[rr][5] * c);
          }
        }
        bf16_t* dst = (bf16_t*)(ws + (isq ? WS_QD : WS_KD)) + ((size_t)hd * T + t) * 192 + ln;
#pragma unroll
        for (int j = 0; j < 6; ++j) dst[32 * j] = f2bf(x[rr][j]);
      } else {
        bf16_t* dst = (bf16_t*)(ws + WS_VDT) + (size_t)hd * 128 * T + (size_t)(t >> 6) * 8192 + (permkey(t) & 63);
#pragma unroll
        for (int j = 0; j < 4; ++j) dst[(ln + 32 * j) * 64] = f2bf(x[rr][j] * rstd_in);
      }
    }
  }
}

NI void dn_chunk_local(const P& p, int dh, int n, char* lds) {
  char* ws = p.ws;
  const int dir = dh >> 2, hd = dh & 3, tid = get_tid();
  float* kS = (float*)lds;
  float* qS = kS + 64 * 33;
  float* Ls = qS + 64 * 33;
  float* gcS = Ls + 64 * 64;
  float* bS = gcS + 64;
  float* egS = bS + 64;
  const float* CQ = (const float*)(ws + WS_CQKV);
  const float* BG = (const float*)(ws + WS_BG);
  const int row0 = pos2row(dir, n * 64), rstep = dir ? -1 : 1;
  const long rstride = (long)rstep * 1536;
  if (tid < 64) {
    const int row = row0 + rstep * tid;
    bS[tid] = BG[(size_t)row * 16 + dir * 8 + hd];
    gcS[tid] = BG[(size_t)row * 16 + dir * 8 + 4 + hd];
  }
  __syncthreads();
  if (tid == 0) { float a = 0.f; for (int i = 0; i < 64; ++i) { a += gcS[i]; gcS[i] = a; } }
  __syncthreads();
  if (tid < 64) egS[tid] = expf(gcS[tid]);
  const int c = tid & 63, sg = tid >> 6;
  float akk[16], aqk[16];
#pragma unroll
  for (int i = 0; i < 16; ++i) { akk[i] = 0.f; aqk[i] = 0.f; }
  float pq[8], pk[8];
#define CL_LOAD(d0) do { _Pragma("unroll") for (int i = 0; i < 8; ++i) { const int idx = tid + 256 * i, rr = idx >> 5, dd = idx & 31; \
      const float* src = CQ + (size_t)(row0 + rstep * rr) * 1536 + hd * 128 + (d0) + dd; pq[i] = src[0]; pk[i] = src[512]; } } while (0)
  CL_LOAD(0);
  for (int d0 = 0; d0 < 128; d0 += 32) {
    __syncthreads();
#pragma unroll
    for (int i = 0; i < 8; ++i) { const int idx = tid + 256 * i, rr = idx >> 5, dd = idx & 31; qS[rr * 33 + dd] = pq[i]; kS[rr * 33 + dd] = pk[i]; }
    __syncthreads();
    if (d0 + 32 < 128) CL_LOAD(d0 + 32);
    for (int d = 0; d < 32; ++d) {
      const float kc = kS[c * 33 + d], qc = qS[c * 33 + d];
#pragma unroll
      for (int i = 0; i < 16; ++i) { const float ks = kS[(sg * 16 + i) * 33 + d]; akk[i] += kc * ks; aqk[i] += qc * ks; }
    }
  }
#undef CL_LOAD
  {
    const float gc_c = gcS[c], beta_c = bS[c];
    bf16_t* QKo = (bf16_t*)(ws + WS_DQK) + ((size_t)(dh * NCH + n) * 64 + c) * 64;
#pragma unroll
    for (int i = 0; i < 16; ++i) {
      const int s = sg * 16 + i;
      const float dec = (c >= s) ? expf(gc_c - gcS[s]) : 0.f;
      Ls[c * 64 + s] = (c > s) ? beta_c * akk[i] * dec : 0.f;
      QKo[s] = f2bf(aqk[i] * dec);
    }
  }
  __syncthreads();
  {
    const int col = tid;
    float x[64];
    const float* src = CQ + (size_t)row0 * 1536 + hd * 128 + (col < 128 ? 1024 + col : 512 + (col - 128));
#pragma unroll
    for (int hb = 0; hb < 2; ++hb) {
#pragma unroll
      for (int i = hb * 32; i < hb * 32 + 32; ++i) {
        const float f = (col < 128) ? bS[i] : bS[i] * egS[i];
        x[i] = src[(long)i * rstride] * f;
      }
      __builtin_amdgcn_sched_barrier(0);
#pragma unroll
      for (int i = hb * 32; i < hb * 32 + 32; ++i) {
        float a = x[i];
#pragma unroll
        for (int j = 0; j < i; ++j) a -= Ls[i * 64 + j] * x[j];
        x[i] = a;
        if ((i & 3) == 3) __builtin_amdgcn_sched_barrier(0);
      }
    }
    if (col < 128) {
      uint4* dst = (uint4*)((bf16_t*)(ws + WS_DU) + ((size_t)(dh * NCH + n) * 128 + col) * 64);
#pragma unroll
      for (int i = 0; i < 8; ++i) dst[i] = make_uint4(pk2(x[8 * i], x[8 * i + 1]), pk2(x[8 * i + 2], x[8 * i + 3]), pk2(x[8 * i + 4], x[8 * i + 5]), pk2(x[8 * i + 6], x[8 * i + 7]));
    } else {
      bf16_t* dst = (bf16_t*)(ws + WS_DW) + ((size_t)dh * T + n * 64) * 128 + (col - 128);
#pragma unroll
      for (int i = 0; i < 64; ++i) dst[(size_t)i * 128] = f2bf(x[i]);
    }
  }
  {
    const float glast = gcS[63];
    const int d = tid & 127, cg2 = tid >> 7;
    bf16_t* qd = (bf16_t*)(ws + WS_DQ) + ((size_t)dh * T + n * 64) * 128;
    {
      float tq[32];
      const float* qsrc = CQ + (size_t)(row0 + rstep * (cg2 * 32)) * 1536 + hd * 128 + d;
#pragma unroll
      for (int i = 0; i < 32; ++i) tq[i] = qsrc[(long)i * rstride];
#pragma unroll
      for (int i = 0; i < 32; ++i) qd[(size_t)(cg2 * 32 + i) * 128 + d] = f2bf(tq[i] * egS[cg2 * 32 + i]);
    }
    bf16_t* kt = (bf16_t*)(ws + WS_DKT) + ((size_t)dh * NCH + n) * 128 * 64;
    const float kf = expf(glast - gcS[c]);
    const float* ksrc = CQ + (size_t)(row0 + rstep * c) * 1536 + 512 + hd * 128;
    {
      float4 tk[8];
#pragma unroll
      for (int i = 0; i < 8; ++i) tk[i] = *(const float4*)(ksrc + sg * 32 + 4 * i);
#pragma unroll
      for (int i = 0; i < 8; ++i) {
        bf16_t* kd = kt + (sg * 32 + 4 * i) * 64 + c;
        kd[0] = f2bf(tk[i].x * kf); kd[64] = f2bf(tk[i].y * kf); kd[128] = f2bf(tk[i].z * kf); kd[192] = f2bf(tk[i].w * kf);
      }
    }
    if (tid == 0) ((float*)(ws + WS_DGL))[dh * NCH + n] = glast;
  }
}

NI void dn_scan(const P& p, int dh, int sl, char* lds) {
  char* ws = p.ws;
  char* ST = lds;
  char* VT = lds + 8704;
  const int tid = get_tid(), w = tid >> 6, lane = tid & 63, r = lane & 31, h = lane >> 5, mt = w & 1;
  const bf16_t* __restrict__ UT = (const bf16_t*)(ws + WS_DU) + (size_t)dh * NCH * 8192 + (size_t)(sl * 32 + r) * 64 + mt * 32 + 4 * h;
  const bf16_t* __restrict__ A1 = (const bf16_t*)(ws + (w < 2 ? WS_DW : WS_DQ)) + (size_t)dh * T * 128 + (size_t)(mt * 32 + r) * 128 + h * 8;
  const bf16_t* __restrict__ QK = (const bf16_t*)(ws + WS_DQK) + (size_t)dh * NCH * 4096 + (mt * 32 + r) * 64 + h * 8;
  const bf16_t* __restrict__ KT = (const bf16_t*)(ws + WS_DKT) + (size_t)dh * NCH * 8192 + (w * 32 + r) * 64 + h * 8;
  const float* __restrict__ GL = (const float*)(ws + WS_DGL) + dh * NCH;
  float* __restrict__ DO = (float*)(ws + WS_DO) + (size_t)dh * T * 128 + sl * 32 + r;
  for (int i = tid; i < 8704 / 4; i += 256) ((unsigned*)ST)[i] = 0u;
  f32x16 S;
#pragma unroll
  for (int q = 0; q < 16; ++q) S[q] = 0.f;
  bf16x8 c_a1[8], c_qk[4], c_kt[4], n_a1[8], n_qk[4], n_kt[4];
  uint2 c_u[4], n_u[4];
  float c_gl, n_gl;
#define DN_LOAD(X, nn) do { \
    _Pragma("unroll") for (int ks = 0; ks < 8; ++ks) X##_a1[ks] = *(const bf16x8*)(A1 + (size_t)(nn) * 8192 + ks * 16); \
    _Pragma("unroll") for (int ks = 0; ks < 4; ++ks) X##_kt[ks] = *(const bf16x8*)(KT + (size_t)(nn) * 8192 + ks * 16); \
    if (w >= 2) { _Pragma("unroll") for (int ks = 0; ks < 4; ++ks) X##_qk[ks] = *(const bf16x8*)(QK + (size_t)(nn) * 4096 + ks * 16); } \
    else { _Pragma("unroll") for (int g = 0; g < 4; ++g) X##_u[g] = *(const uint2*)(UT + (size_t)(nn) * 8192 + 8 * g); } \
    X##_gl = GL[nn]; } while (0)
#pragma unroll
  for (int ks = 0; ks < 4; ++ks) { c_qk[ks] = (bf16x8)(0); n_qk[ks] = (bf16x8)(0); c_u[ks] = make_uint2(0u, 0u); n_u[ks] = make_uint2(0u, 0u); }
  DN_LOAD(c, 0);
  __syncthreads();
  for (int n = 0; n < NCH; ++n) {
    if (n + 1 < NCH) DN_LOAD(n, n + 1);
    const float dec = expf(c_gl);
    f32x16 acc0, acc1;
#pragma unroll
    for (int q = 0; q < 16; ++q) { acc0[q] = 0.f; acc1[q] = 0.f; }
#pragma unroll
    for (int ks = 0; ks < 8; ks += 2) {
      bf16x8 b0 = *(const bf16x8*)(ST + r * 272 + h * 16 + ks * 32);
      bf16x8 b1 = *(const bf16x8*)(ST + r * 272 + h * 16 + (ks + 1) * 32);
      acc0 = MFMA32(c_a1[ks], b0, acc0);
      acc1 = MFMA32(c_a1[ks + 1], b1, acc1);
    }
#pragma unroll
    for (int q = 0; q < 16; ++q) acc0[q] += acc1[q];
    if (w < 2) {
#pragma unroll
      for (int g = 0; g < 4; ++g) {
        const float u0 = __uint_as_float(c_u[g].x << 16), u1 = __uint_as_float(c_u[g].x & 0xffff0000u);
        const float u2 = __uint_as_float(c_u[g].y << 16), u3 = __uint_as_float(c_u[g].y & 0xffff0000u);
        uint2 o;
        o.x = pk2(u0 - acc0[4 * g + 0], u1 - acc0[4 * g + 1]);
        o.y = pk2(u2 - acc0[4 * g + 2], u3 - acc0[4 * g + 3]);
        *(uint2*)(VT + r * 144 + (mt * 4 + g) * 16 + h * 8) = o;
      }
    }
    __syncthreads();
    bf16x8 vb[4];
#pragma unroll
    for (int ks = 0; ks < 4; ++ks) vb[ks] = *(const bf16x8*)(VT + r * 144 + h * 16 + ks * 32);
    if (w >= 2) {
#pragma unroll
      for (int ks = 0; ks < 4; ++ks) acc0 = MFMA32(c_qk[ks], vb[ks], acc0);
#pragma unroll
      for (int q = 0; q < 16; ++q) DO[(size_t)(n * 64 + mt * 32 + crow(q, h)) * 128] = acc0[q];
    }
#pragma unroll
    for (int q = 0; q < 16; ++q) S[q] *= dec;
#pragma unroll
    for (int ks = 0; ks < 4; ++ks) S = MFMA32(c_kt[ks], vb[ks], S);
#pragma unroll
    for (int g = 0; g < 4; ++g) {
      uint2 o;
      o.x = pk2(S[4 * g + 0], S[4 * g + 1]); o.y = pk2(S[4 * g + 2], S[4 * g + 3]);
      *(uint2*)(ST + r * 272 + (w * 4 + g) * 16 + h * 8) = o;
    }
#pragma unroll
    for (int ks = 0; ks < 8; ++ks) c_a1[ks] = n_a1[ks];
#pragma unroll
    for (int ks = 0; ks < 4; ++ks) { c_kt[ks] = n_kt[ks]; c_qk[ks] = n_qk[ks]; c_u[ks] = n_u[ks]; }
    c_gl = n_gl;
    __syncthreads();
  }
#undef DN_LOAD
}

NI void lru_scan(const P& p, int l, int dir, int cgp, char* lds) {
  char* ws = p.ws;
  const int tid = get_tid(), ch = tid & 7, seg = tid >> 3, c = cgp * 8 + ch;
  const float* __restrict__ LA = (const float*)(ws + WS_G) + (size_t)dir * T * 512 + c;
  const float* __restrict__ LB = (const float*)(ws + WS_G) + (size_t)(2 + dir) * T * 512 + c;
  float* __restrict__ HL = (float*)(ws + WS_HL) + (size_t)dir * T * 512 + c;
  float* sA = (float*)lds; float* sB = sA + 256;
  const int p0 = seg * 264;
  float Aa = 1.f, Bb = 0.f;
  for (int q = 0; q < 264; q += 12) {
    float av[12], bv[12];
#pragma unroll
    for (int u = 0; u < 12; ++u) { const size_t ro = (size_t)pos2row(dir, p0 + q + u) * 512; av[u] = LA[ro]; bv[u] = LB[ro]; }
#pragma unroll
    for (int u = 0; u < 12; ++u) { Bb = av[u] * Bb + bv[u]; Aa *= av[u]; }
  }
  sA[seg * 8 + ch] = Aa; sB[seg * 8 + ch] = Bb;
  __syncthreads();
  float hh = 0.f;
  for (int s2 = 0; s2 < seg; ++s2) hh = sA[s2 * 8 + ch] * hh + sB[s2 * 8 + ch];
  for (int q = 0; q < 264; q += 12) {
    float av[12], bv[12]; size_t ro[12];
#pragma unroll
    for (int u = 0; u < 12; ++u) { ro[u] = (size_t)pos2row(dir, p0 + q + u) * 512; av[u] = LA[ro[u]]; bv[u] = LB[ro[u]]; }
#pragma unroll
    for (int u = 0; u < 12; ++u) { hh = av[u] * hh + bv[u]; HL[ro[u]] = hh; }
  }
  (void)l;
}

NI void post_row(const P& p, int l, int t0) {
  char* ws = p.ws;
  const bf16_t* __restrict__ U = (const bf16_t*)(ws + WS_U);
  bf16_t* Y = (bf16_t*)(ws + WS_Y);
  const int tid = get_tid(), hw = tid >> 5, ln = tid & 31;
  if (hw < 4) {
    const int hd = hw;
    float x[RB][4], z[RB][4], nw[4];
#pragma unroll
    for (int rr = 0; rr < RB; ++rr) {
      const int t = t0 + rr, pb = t < NCTX ? NCTX - 1 - t : (T + NCTX - 1) - t;
      const float* of = (const float*)(ws + WS_DO) + ((size_t)hd * T + t) * 128 + ln;
      const float* ob = (const float*)(ws + WS_DO) + ((size_t)(4 + hd) * T + pb) * 128 + ln;
#pragma unroll
      for (int j = 0; j < 4; ++j) { x[rr][j] = of[32 * j] + ob[32 * j]; z[rr][j] = bf2f(U[(size_t)t * INP + O_CZ + hd * 128 + ln + 32 * j]); }
    }
#pragma unroll
    for (int j = 0; j < 4; ++j) nw[j] = p.in[I_DNW][l * 128 + ln + 32 * j];
#pragma unroll
    for (int rr = 0; rr < RB; ++rr) {
      float ss = x[rr][0] * x[rr][0] + x[rr][1] * x[rr][1] + x[rr][2] * x[rr][2] + x[rr][3] * x[rr][3];
      const float rstd = rsqrtf(hw_sum(ss) * (1.f / 128.f) + EPS);
#pragma unroll
      for (int j = 0; j < 4; ++j) Y[tiled_off(t0 + rr, 1024 + hd * 128 + ln + 32 * j)] = f2bf(x[rr][j] * rstd * nw[j] * siluf(z[rr][j]));
    }
  } else {
    const int sg = hw - 4;
    float hsum[RB][4], z[RB][4];
#pragma unroll
    for (int rr = 0; rr < RB; ++rr) {
      const float* h0 = (const float*)(ws + WS_HL) + (size_t)(t0 + rr) * 512 + sg * 128 + ln;
      const float* h1 = h0 + (size_t)T * 512;
#pragma unroll
      for (int j = 0; j < 4; ++j) { hsum[rr][j] = h0[32 * j] + h1[32 * j]; z[rr][j] = bf2f(U[(size_t)(t0 + rr) * INP + O_BZ + sg * 128 + ln + 32 * j]); }
    }
#pragma unroll
    for (int rr = 0; rr < RB; ++rr)
#pragma unroll
      for (int j = 0; j < 4; ++j) Y[tiled_off(t0 + rr, 512 + sg * 128 + ln + 32 * j)] = f2bf(hsum[rr][j] * siluf(z[rr][j]));
  }
}

constexpr int N_PHASES = 1 + NL * 7;
__global__ void __launch_bounds__(256, 2) mega(P p) {
  __shared__ __attribute__((aligned(16))) char lds[73728];
  __shared__ int s_item;
  char* ws = p.ws;
  unsigned* ctrs = (unsigned*)(ws + WS_CTR);
  unsigned bar_k = 0, n_x = 0, nxcd = 0;
  const unsigned myx = (unsigned)xcc_id();
  if (threadIdx.x == 0) __hip_atomic_fetch_add((unsigned*)(ws + WS_BAR) + 32 * (20 + myx), 1u, __ATOMIC_RELAXED, __HIP_MEMORY_SCOPE_AGENT);
  for (int ph2 = 2 * p.ph_lo; ph2 < 2 * p.ph_hi; ++ph2) {
    const int ph = ph2 >> 1;
    const bool rep_this = (REP_K >= 0 && ph > 0 && (ph - 1) % 7 == REP_K) || (REP_K == 7 && ph == 0);
    if ((ph2 & 1) && !rep_this) continue;
    unsigned* ctr = ctrs + ph + 32 * (ph2 & 1);
    if (ph == 0 && EN(0)) {
      phase0(p, ctr, &s_item, lds);
    } else {
      const int l = (ph - 1) / 7, k = (ph - 1) % 7;
      const float* modl = (const float*)(ws + WS_MOD) + (size_t)l * 2 * 6144;
      bf16_t* U = (bf16_t*)(ws + WS_U);
      if (k == 0 && EN(1)) {
        phase_norm(p, l, ctr, &s_item, lds);
      } else if (k == 1 && EN(2)) {
        Epi e{}; e.cb = U; e.cf = (float*)(ws + WS_AB);
        const bf16_t* Bt = (const bf16_t*)(ws + WS_WTIN) + (size_t)l * INP * LDP;
        const int g0 = xcc_id();
        for (int gi = 0; gi < 8; ++gi) {
          const int g = (g0 + gi) & 7;
          unsigned* gctr = ctrs + 128 + ph2 * 8 + g;
          int tm, tn;
          int i = next_item(gctr, &s_item);
          while (xcd_tile(g, i, 66, 46, tm, tn)) {
            unsigned pend = 0;
            if (threadIdx.x == 0) pend = atomicAdd(gctr, 1u);
            gemm_tile<0, true>((const bf16_t*)(ws + WS_H), LDP, Bt, LDP, DM, tm * 128, tn * 128, lds, e);
            __syncthreads();
            if (threadIdx.x == 0) s_item = (int)pend;
            __syncthreads();
            i = s_item;
          }
        }
      } else if (k == 2 && EN(3)) {
        constexpr int NG = 66 * 6 + 66 * 8;
        ITEMS_STATIC(item, NG + T / 4) {
          if (item < 66 * 6) {
            Epi e{}; e.cb = (bf16_t*)(ws + WS_QDR); e.ldc = 768;
            gemm_tile<1>(U + O_DCQ, INP, (const bf16_t*)(ws + WS_WTUQ) + (size_t)l * 768 * 384, 384, 384, (item / 6) * 128, (item % 6) * 128, lds, e);
          } else if (item < NG) {
            const int it = item - 66 * 6;
            Epi e{}; e.cb = (bf16_t*)(ws + WS_KVDR); e.ldc = 1024;
            gemm_tile<1>(U + O_DCKV, INP, (const bf16_t*)(ws + WS_WTUKV) + (size_t)l * 1024 * 256, 256, 256, (it / 8) * 128, (it % 8) * 128, lds, e);
          } else {
            const int r0 = (item - NG) * 4;
            prepA_row(p, l, r0);
          }
        }
      } else if (k == 3 && EN(4)) {
        constexpr int NC = 8 * NCH, NGT = 66 * 16;
        ITEMS_STATIC(item, NC + NGT + T / 4) {
          if (item < NC) {
            if (ENS(0)) dn_chunk_local(p, item / NCH, item % NCH, lds);
          } else if (item < NC + NGT) {
            const int it = item - NC, mtile = it >> 4, ntile = it & 15;
            Epi e{}; e.bias0 = p.in[I_LBA] + l * 1024; e.bias1 = p.in[I_LBX] + l * 1024; e.lam = p.in[I_LLAM] + l * 1024;
            e.xl = (const float*)(ws + WS_XL); e.la = (float*)(ws + WS_G); e.lb = (float*)(ws + WS_G) + (size_t)2 * T * 512;
            gemm_tile<2>((const bf16_t*)(ws + WS_XLB) + ((ntile >> 1) & 3) * 128, 512, (const bf16_t*)(ws + WS_WTLRU) + (size_t)l * 2048 * 128, 128, 128,
                         mtile * 128, ntile * 128, lds, e);
          } else {
            const int r0 = (item - NC - NGT) * 4;
            prepD_row(p, l, r0); prepD_row(p, l, r0 + 2);
          }
        }
      } else if (k == 4 && EN(5)) {
        const int g0 = xcc_id();
        for (int gi = 0; gi < 8; ++gi) {
        const int g = (g0 + gi) & 7;
        unsigned* gctr = ctrs + 128 + ph2 * 8 + g;
        const int tot = (g < 4) ? 84 : 88;
        for (int i = next_item(gctr, &s_item); i < tot; i = next_item(gctr, &s_item)) {
          if (g < 4) {
            if (i < 16) { const int li = 64 + g * 16 + i; for (int rp = 0; rp < (REP_SUB == 2 ? 2 : 1); ++rp) { lru_scan(p, l, li >> 6, li & 63, lds); __syncthreads(); } }
            else if (i < 20) {
              const int it = g * 4 + (i - 16), mixer = it >> 3, hd = (it >> 1) & 3, qb = it & 1;
              if (mixer == 0)
                attn_item<192>((const bf16_t*)(ws + WS_QD) + (size_t)hd * T * 192, (const bf16_t*)(ws + WS_KD) + (size_t)hd * T * 192,
                               (const bf16_t*)(ws + WS_VDT) + (size_t)hd * 128 * T, qb * 128, 4, U + O_DZ + hd * 128,
                               (bf16_t*)(ws + WS_Y), 1536 + hd * 128, 0.07216878364870322f * 1.4426950408889634f, lds);
              else
                attn_item<128>((const bf16_t*)(ws + WS_QA) + (size_t)hd * T * 128, (const bf16_t*)(ws + WS_KA) + (size_t)(hd >> 1) * T * 128,
                               (const bf16_t*)(ws + WS_VAT) + (size_t)(hd >> 1) * 128 * T, qb * 128, 4, U + O_AZ + hd * 128,
                               (bf16_t*)(ws + WS_Y), hd * 128, 0.08838834764831845f * 1.4426950408889634f, lds);
            } else {
              const int hd = g, qb = i - 20;
              for (int rp = 0; rp < (REP_SUB == 3 ? 2 : 1); ++rp)
              attn_item<192>((const bf16_t*)(ws + WS_QD) + (size_t)hd * T * 192, (const bf16_t*)(ws + WS_KD) + (size_t)hd * T * 192,
                             (const bf16_t*)(ws + WS_VDT) + (size_t)hd * 128 * T, NCTX + qb * 128, NCH, U + O_DZ + hd * 128,
                             (bf16_t*)(ws + WS_Y), 1536 + hd * 128, 0.07216878364870322f * 1.4426950408889634f, lds);
            }
          } else {
            if (i < 8) { const int di = (g - 4) * 8 + i; for (int rp = 0; rp < (REP_SUB == 1 ? 2 : 1); ++rp) { dn_scan(p, di >> 2, di & 3, lds); __syncthreads(); } }
            else if (i < 24) { const int li = (g - 4) * 16 + (i - 8); for (int rp = 0; rp < (REP_SUB == 2 ? 2 : 1); ++rp) { lru_scan(p, l, li >> 6, li & 63, lds); __syncthreads(); } }
            else {
              const int hd = g - 4, qb = i - 24;
              for (int rp = 0; rp < (REP_SUB == 3 ? 2 : 1); ++rp)
              attn_item<128>((const bf16_t*)(ws + WS_QA) + (size_t)hd * T * 128, (const bf16_t*)(ws + WS_KA) + (size_t)(hd >> 1) * T * 128,
                             (const bf16_t*)(ws + WS_VAT) + (size_t)(hd >> 1) * 128 * T, NCTX + qb * 128, NCH, U + O_AZ + hd * 128,
                             (bf16_t*)(ws + WS_Y), hd * 128, 0.08838834764831845f * 1.4426950408889634f, lds);
            }
          }
        }
        }
      } else if (k == 5 && EN(6)) {
        ITEMS_STATIC(item, T / 4)
          post_row(p, l, item * 4);
      } else if (k == 6 && EN(7)) {
        Epi e{};
        e.xin_ctx = (l == 0) ? p.in[I_CTX] : (const float*)(ws + WS_X);
        e.xin_lat = (l == 0) ? p.in[I_X] : (const float*)(ws + WS_X) + (size_t)NCTX * DM;
        e.xout = (float*)(ws + WS_X); e.out = p.out;
        e.gate_lat = modl + 4096; e.gate_ctx = modl + 6144 + 4096; e.last = (l == NL - 1);
        const bf16_t* Bt = (const bf16_t*)(ws + WS_WTOUT) + (size_t)l * DM * LDP;
        const int g0 = xcc_id();
        for (int gi = 0; gi < 8; ++gi) {
          const int g = (g0 + gi) & 7;
          unsigned* gctr = ctrs + 128 + ph2 * 8 + g;
          int tm, tn;
          const int mt_n = e.last ? 64 : 66, mt_0 = e.last ? 2 : 0;
          int i = next_item(gctr, &s_item);
          while (xcd_tile(g, i, mt_n, 16, tm, tn)) {
            unsigned pend = 0;
            if (threadIdx.x == 0) pend = atomicAdd(gctr, 1u);
            gemm_tile<3, true>((const bf16_t*)(ws + WS_Y), LDP, Bt, LDP, DM, (tm + mt_0) * 128, tn * 128, lds, e);
            __syncthreads();
            if (threadIdx.x == 0) s_item = (int)pend;
            __syncthreads();
            i = s_item;
          }
        }
      }
    }
    if ((ph + 1 < p.ph_hi) || (rep_this && !(ph2 & 1))) {
      if (ph == 0 && !(ph2 & 1)) {
        cg::this_grid().sync();
        for (unsigned x = 0; x < 8; ++x) {
          const unsigned c = __hip_atomic_load((unsigned*)(ws + WS_BAR) + 32 * (20 + x), __ATOMIC_RELAXED, __HIP_MEMORY_SCOPE_AGENT);
          nxcd += (c > 0); if (x == myx) n_x = c;
        }
      } else grid_barrier((unsigned*)(ws + WS_BAR), ++bar_k, myx, n_x, nxcd);
    }
  }
}

extern "C" void kernel_launch(void* const* d_in, const int* in_sizes, int n_in, void* d_out, int out_size, void* d_ws, size_t ws_size, hipStream_t stream) {
  static int grid_blocks = 0;
  if (!grid_blocks) {
    int dev = 0, cus = 0, per_cu = 0;
    hipGetDevice(&dev);
    hipDeviceGetAttribute(&cus, hipDeviceAttributeMultiprocessorCount, dev);
    hipOccupancyMaxActiveBlocksPerMultiprocessor(&per_cu, mega, 256, 0);
    if (per_cu < 1) per_cu = 1;
    if (per_cu > 2) per_cu = 2;
    grid_blocks = cus * per_cu;
    if (ws_size < WS_END) fprintf(stderr, "kernel_launch: workspace too small: %zu < %zu\n", ws_size, (size_t)WS_END);
    fprintf(stderr, "kernel_launch: grid %d (cus %d x %d), ws need %zu have %zu\n", grid_blocks, cus, per_cu, (size_t)WS_END, ws_size);
  }
  if (ws_size < WS_END || n_in < 28) return;
  hipMemsetAsync((char*)d_ws + WS_CTR, 0, 8192, stream);
  P p{};
  for (int i = 0; i < 28; ++i) p.in[i] = (const float*)d_in[i];
  p.out = (float*)d_out; p.ws = (char*)d_ws;
#if MEGA
  p.ph_lo = 0; p.ph_hi = N_PHASES;
  void* args[] = {&p};
  hipError_t e = hipLaunchCooperativeKernel((void*)mega, dim3(grid_blocks), dim3(256), args, 0, stream);
  if (e != hipSuccess) fprintf(stderr, "cooperative launch failed: %s (grid %d)\n", hipGetErrorString(e), grid_blocks);
#else
  for (int ph = 0; ph < N_PHASES; ++ph) {
    p.ph_lo = ph; p.ph_hi = ph + 1;
    hipLaunchKernelGGL(mega, dim3(grid_blocks), dim3(256), 0, stream, p);
  }
#endif
}
```

```cpp
#include <hip/hip_runtime.h>
#include <hip/hip_cooperative_groups.h>
#include <cstdio>
namespace cg = cooperative_groups;

#ifndef MEGA
#define MEGA 1
#endif
#ifndef ONLY
#define ONLY -1
#endif
#define EN(x) (ONLY < 0 || ONLY == (x))
#ifndef REP_SUB
#define REP_SUB 0
#endif
#ifndef REP_K
#define REP_K -1
#endif
#ifndef SUB
#define SUB -1
#endif
#define ENS(x) (SUB < 0 || SUB == (x))

typedef unsigned short bf16_t;
using bf16x8 = __attribute__((ext_vector_type(8))) short;
using f32x16 = __attribute__((ext_vector_type(16))) float;
using u32x4 = __attribute__((ext_vector_type(4))) unsigned;
#define DI __device__ __forceinline__
#define NI __device__ __forceinline__
#define MFMA32(a, b, c) __builtin_amdgcn_mfma_f32_32x32x16_bf16((a), (b), (c), 0, 0, 0)

constexpr int T = 8448, NCTX = 256, DM = 2048, INW = 5840, INP = 5888, NL = 4;
constexpr int O_AQ = 0, O_AK = 512, O_AV = 768, O_AZ = 1024, O_BX = 1536, O_BZ = 2048, O_CQKV = 2560, O_CZ = 4096,
              O_CAB = 4608, O_DCQ = 4624, O_DCKV = 5008, O_DKR = 5264, O_DZ = 5328;
constexpr int LDP = 2112;
constexpr int NCH = 132;
constexpr float EPS = 1e-6f;

constexpr size_t al256(size_t x) { return (x + 255) / 256 * 256; }
constexpr size_t WS_CTR = 0;
constexpr size_t WS_BAR = 4096;
constexpr size_t WS_WTIN = 8192;
constexpr size_t WS_WTOUT = WS_WTIN + al256((size_t)NL * INP * LDP * 2);
constexpr size_t WS_WTUQ = WS_WTOUT + al256((size_t)NL * DM * LDP * 2);
constexpr size_t WS_WTUKV = WS_WTUQ + al256((size_t)NL * 768 * 384 * 2);
constexpr size_t WS_WTLRU = WS_WTUKV + al256((size_t)NL * 1024 * 256 * 2);
constexpr size_t WS_MOD = WS_WTLRU + al256((size_t)NL * 2048 * 128 * 2);
constexpr size_t WS_X = WS_MOD + al256((size_t)NL * 2 * 6144 * 4);
constexpr size_t WS_H = WS_X + al256((size_t)T * DM * 4);
constexpr size_t WS_U = WS_H + al256((size_t)T * LDP * 2);
constexpr size_t WS_AB = WS_U + al256((size_t)T * INP * 2);
constexpr size_t WS_QA = WS_AB + al256((size_t)T * 16 * 4);
constexpr size_t WS_KA = WS_QA + al256((size_t)4 * T * 128 * 2);
constexpr size_t WS_VAT = WS_KA + al256((size_t)2 * T * 128 * 2);
constexpr size_t WS_QDR = WS_VAT + al256((size_t)2 * T * 128 * 2);
constexpr size_t WS_KVDR = WS_QDR + al256((size_t)T * 768 * 2);
constexpr size_t WS_QD = WS_KVDR + al256((size_t)T * 1024 * 2);
constexpr size_t WS_KD = WS_QD + al256((size_t)4 * T * 192 * 2);
constexpr size_t WS_VDT = WS_KD + al256((size_t)4 * T * 192 * 2);
constexpr size_t WS_XL = WS_VDT + al256((size_t)4 * T * 128 * 2);
constexpr size_t WS_XLB = WS_XL + al256((size_t)T * 512 * 4);
constexpr size_t WS_G = WS_XLB + al256((size_t)T * 512 * 2);
constexpr size_t WS_HL = WS_G + al256((size_t)T * 2048 * 4);
constexpr size_t WS_CQKV = WS_HL + al256((size_t)2 * T * 512 * 4);
constexpr size_t WS_BG = WS_CQKV + al256((size_t)T * 1536 * 4);
constexpr size_t WS_DU = WS_BG + al256((size_t)T * 16 * 4);
constexpr size_t WS_DW = WS_DU + al256((size_t)8 * T * 128 * 2);
constexpr size_t WS_DQ = WS_DW + al256((size_t)8 * T * 128 * 2);
constexpr size_t WS_DKT = WS_DQ + al256((size_t)8 * T * 128 * 2);
constexpr size_t WS_DQK = WS_DKT + al256((size_t)8 * T * 128 * 2);
constexpr size_t WS_DGL = WS_DQK + al256((size_t)8 * NCH * 64 * 64 * 2);
constexpr size_t WS_DO = WS_DGL + al256((size_t)8 * NCH * 4);
constexpr size_t WS_Y = WS_DO + al256((size_t)8 * T * 128 * 4);
constexpr size_t WS_END = WS_Y + al256((size_t)T * LDP * 2);

struct P {
  const float* in[28];
  float* out;
  char* ws;
  int ph_lo, ph_hi;
};
enum { I_X = 0, I_C, I_CTX, I_CCTX, I_NORMW, I_WADA, I_BADA, I_WIN, I_WOUT, I_AQN, I_AKN, I_LCW, I_LCB, I_LWA, I_LBA, I_LWX, I_LBX,
       I_LLAM, I_DCW, I_DALOG, I_DDT, I_DNW, I_MQN, I_MKVN, I_MWUQ, I_MWUKV, I_MQQK, I_MKQK };

DI float bf2f(bf16_t b) { return __uint_as_float(((unsigned)b) << 16); }
DI bf16_t f2bf(float x) { unsigned u = __float_as_uint(x); u += 0x7fffu + ((u >> 16) & 1u); return (bf16_t)(u >> 16); }
DI unsigned pk2(float lo, float hi) { return (unsigned)f2bf(lo) | ((unsigned)f2bf(hi) << 16); }
DI float siluf(float x) { return x / (1.f + __expf(-x)); }
DI float sigm(float x) { return 1.f / (1.f + __expf(-x)); }
DI float softplusf(float x) { return x > 20.f ? x : log1pf(expf(x)); }
DI size_t tiled_off(int row, int col) { return ((size_t)((row >> 7) * 32 + (col >> 6)) << 13) + (row & 127) * 64 + (col & 63); }
DI int crow(int reg, int h) { return (reg & 3) + 8 * (reg >> 2) + 4 * h; }
DI int permkey(int t) { return (t & ~0xC) | ((t & 4) << 1) | ((t & 8) >> 1); }
DI int pos2row(int dir, int p) { return dir == 0 ? p : (p < NCTX ? NCTX - 1 - p : (T + NCTX - 1) - p); }
DI float hw_sum(float v) {
  v += __shfl_xor(v, 16); v += __shfl_xor(v, 8); v += __shfl_xor(v, 4); v += __shfl_xor(v, 2); v += __shfl_xor(v, 1); return v;
}
DI void sincos_rev(float ang, float& s, float& c) {
  float rev = ang * 0.15915494309189535f; rev -= rintf(rev);
  s = __builtin_amdgcn_sinf(rev); c = __builtin_amdgcn_cosf(rev);
}
DI unsigned cvtpk(float lo, float hi) { unsigned r; asm volatile("v_cvt_pk_bf16_f32 %0, %1, %2" : "=v"(r) : "v"(lo), "v"(hi)); return r; }
DI bf16x8 pack8(const f32x16& x, int s) {
  union { unsigned u[4]; bf16x8 v; } t;
  t.u[0] = cvtpk(x[8 * s + 0], x[8 * s + 1]); t.u[1] = cvtpk(x[8 * s + 2], x[8 * s + 3]);
  t.u[2] = cvtpk(x[8 * s + 4], x[8 * s + 5]); t.u[3] = cvtpk(x[8 * s + 6], x[8 * s + 7]);
  return t.v;
}
DI int get_tid() { int t = threadIdx.x; asm volatile("" : "+v"(t)); return t; }
DI int xcc_id() { return (int)(__builtin_amdgcn_s_getreg((3 << 11) | 20) & 7u); }
DI void grid_barrier(unsigned* bar, unsigned k, unsigned myx, unsigned n_x, unsigned nxcd) {
  __syncthreads();
  if (threadIdx.x == 0) {
    unsigned* cx = bar + 32 * myx; unsigned* l2 = bar + 32 * 16; unsigned* flag = bar + 32 * 17;
    const unsigned a = __hip_atomic_fetch_add(cx, 1u, __ATOMIC_RELAXED, __HIP_MEMORY_SCOPE_AGENT);
    if (a + 1 == k * n_x) {
      __builtin_amdgcn_fence(__ATOMIC_RELEASE, "agent");
      const unsigned b = __hip_atomic_fetch_add(l2, 1u, __ATOMIC_RELAXED, __HIP_MEMORY_SCOPE_AGENT);
      if (b + 1 == k * nxcd) __hip_atomic_store(flag, k, __ATOMIC_RELAXED, __HIP_MEMORY_SCOPE_AGENT);
    }
    while (__hip_atomic_load(flag, __ATOMIC_RELAXED, __HIP_MEMORY_SCOPE_AGENT) < k) __builtin_amdgcn_s_sleep(4);
    __builtin_amdgcn_fence(__ATOMIC_ACQUIRE, "agent");
  }
  __syncthreads();
}
DI int next_item(unsigned* ctr, int* s_item) {
  __syncthreads();
  if (threadIdx.x == 0) *s_item = (int)atomicAdd(ctr, 1u);
  __syncthreads();
  return *s_item;
}

DI bool xcd_tile(int g, int i, int MT, int NT, int& m, int& n) {
  const int idx = (((i >> 6) * 8 + g) << 6) + (i & 63);
  if (idx >= MT * NT) return false;
  const int full = NT >> 3, wr = NT & 7, fp = full * MT * 8;
  if (idx < fp) { const int pnl = idx / (MT * 8), rem = idx % (MT * 8); m = rem >> 3; n = pnl * 8 + (rem & 7); }
  else { const int rem = idx - fp; m = rem / wr; n = full * 8 + rem % wr; }
  return true;
}
#define ITEMS_STATIC(item, total) for (int item = (__syncthreads(), (int)blockIdx.x); item < (total); item = (__syncthreads(), item + (int)gridDim.x))
struct Epi {
  bf16_t* cb; int ldc;
  float* cf;
  const float* bias0; const float* bias1;
  const float* xin_lat; const float* xin_ctx;
  float* xout; float* out;
  const float* gate_lat; const float* gate_ctx;
  int last;
  const float* lam; const float* xl; float* la; float* lb;
};
template <int EPI>
DI void epi_store(const Epi& e, int row, int col, float v) {
  if constexpr (EPI == 0) {
    e.cb[(size_t)row * INP + col] = f2bf(v);
    if (col >= O_CAB && col < O_CAB + 16) e.cf[row * 16 + (col - O_CAB)] = v;
  } else if constexpr (EPI == 1) {
    e.cb[(size_t)row * e.ldc + col] = f2bf(v);
  } else if constexpr (EPI == 2) {
  } else {
    float xo, g;
    if (row < NCTX) { xo = e.xin_ctx[(size_t)row * DM + col]; g = e.gate_ctx[col]; }
    else { xo = e.xin_lat[(size_t)(row - NCTX) * DM + col]; g = e.gate_lat[col]; }
    float xn = xo + g * v;
    if (e.last) { if (row >= NCTX) e.out[(size_t)(row - NCTX) * DM + col] = xn; }
    else e.xout[(size_t)row * DM + col] = xn;
  }
}
template <int EPI, bool TILED = false>
NI void gemm_tile(const bf16_t* __restrict__ A, int lda, const bf16_t* __restrict__ Bt, int ldb, int K, int m0, int n0, char* lds, const Epi& ep) {
  char* As = lds; char* Bs = lds + 36864;
  const int tid = get_tid(), w = tid >> 6, lane = tid & 63, r = lane & 31, h = lane >> 5, wm = w >> 1, wn = w & 1;
  f32x16 acc[2][2];
#pragma unroll
  for (int i = 0; i < 2; ++i)
#pragma unroll
    for (int j = 0; j < 2; ++j)
#pragma unroll
      for (int q = 0; q < 16; ++q) acc[i][j][q] = 0.f;
  u32x4 ar0[4], br0[4], ar1[4], br1[4];
  const int srow = tid >> 3, sch = tid & 7;
  const bf16_t* Ag = TILED ? A + ((size_t)(m0 >> 7) * 32 << 13) + srow * 64 + sch * 8 : A + (size_t)(m0 + srow) * lda + sch * 8;
  const bf16_t* Bg = TILED ? Bt + ((size_t)(n0 >> 7) * 32 << 13) + srow * 64 + sch * 8 : Bt + (size_t)(n0 + srow) * ldb + sch * 8;
  const size_t a_rs = TILED ? 64 : lda, b_rs = TILED ? 64 : ldb, k_st = TILED ? 8192 : 64;
  const int KT = K >> 6;
#define G_LOAD(S, kt) do { _Pragma("unroll") for (int i = 0; i < 4; ++i) { \
      ar##S[i] = *(const u32x4*)(Ag + (size_t)(32 * i) * a_rs + (size_t)(kt) * k_st); br##S[i] = *(const u32x4*)(Bg + (size_t)(32 * i) * b_rs + (size_t)(kt) * k_st); } } while (0)
#define G_STORE(S, buf) do { _Pragma("unroll") for (int i = 0; i < 4; ++i) { int off = (srow + 32 * i) * 144 + sch * 16; \
      *(u32x4*)(As + (buf) * 18432 + off) = ar##S[i]; *(u32x4*)(Bs + (buf) * 18432 + off) = br##S[i]; } } while (0)
#define G_COMPUTE(buf) do { \
    const char* Ab = As + (buf) * 18432 + (wm * 64 + r) * 144 + h * 16; const char* Bb = Bs + (buf) * 18432 + (wn * 64 + r) * 144 + h * 16; \
    _Pragma("unroll") for (int ks = 0; ks < 4; ++ks) { \
      bf16x8 a[2], b[2]; \
      _Pragma("unroll") for (int i = 0; i < 2; ++i) a[i] = *(const bf16x8*)(Ab + i * 32 * 144 + ks * 32); \
      _Pragma("unroll") for (int j = 0; j < 2; ++j) b[j] = *(const bf16x8*)(Bb + j * 32 * 144 + ks * 32); \
      _Pragma("unroll") for (int i = 0; i < 2; ++i) \
        _Pragma("unroll") for (int j = 0; j < 2; ++j) acc[i][j] = MFMA32(a[i], b[j], acc[i][j]); \
    } } while (0)
  G_LOAD(0, 0); G_LOAD(1, 1); G_STORE(0, 0); __syncthreads();
  for (int kt = 0; kt < KT; kt += 2) {
    G_LOAD(0, (kt + 2 < KT) ? kt + 2 : 0);
    G_COMPUTE(0);
    G_STORE(1, 1);
    __syncthreads();
    G_LOAD(1, (kt + 3 < KT) ? kt + 3 : 1);
    G_COMPUTE(1);
    if (kt + 2 < KT) G_STORE(0, 0);
    __syncthreads();
  }
#undef G_COMPUTE
#undef G_LOAD
#undef G_STORE
  if constexpr (EPI == 2) {
    const int nt = n0 >> 7, dir = nt >> 3, ch = ((nt >> 1) & 3) * 128 + (nt & 1) * 64 + wn * 32 + r;
    const float ba = ep.bias0[dir * 512 + ch], bx = ep.bias1[dir * 512 + ch];
    const float sp = softplusf(-ep.lam[dir * 512 + ch]);
    float* la = ep.la + (size_t)dir * T * 512 + ch; float* lb = ep.lb + (size_t)dir * T * 512 + ch;
    float xlv[2][16];
#pragma unroll
    for (int i = 0; i < 2; ++i)
#pragma unroll
      for (int q = 0; q < 16; ++q) xlv[i][q] = ep.xl[(size_t)(m0 + wm * 64 + i * 32 + crow(q, h)) * 512 + ch];
#pragma unroll
    for (int i = 0; i < 2; ++i)
#pragma unroll
      for (int q = 0; q < 16; ++q) {
        const int row = m0 + wm * 64 + i * 32 + crow(q, h);
        const float rg = sigm(acc[i][0][q] + ba), ig = sigm(acc[i][1][q] + bx), xv = xlv[i][q];
        const float lg = -8.f * rg * sp;
        la[(size_t)row * 512] = expf(lg);
        lb[(size_t)row * 512] = sqrtf(-expm1f(2.f * lg)) * (ig * xv);
      }
  } else if constexpr (EPI == 3) {
    const bool isctx = m0 < NCTX;
    const float* xin = isctx ? ep.xin_ctx + (size_t)m0 * DM : ep.xin_lat + (size_t)(m0 - NCTX) * DM;
    const int colb = n0 + wn * 64 + r;
    float gt[2], xo[2][2][16];
#pragma unroll
    for (int j = 0; j < 2; ++j) gt[j] = (isctx ? ep.gate_ctx : ep.gate_lat)[colb + j * 32];
#pragma unroll
    for (int i = 0; i < 2; ++i)
#pragma unroll
      for (int j = 0; j < 2; ++j)
#pragma unroll
        for (int q = 0; q < 16; ++q) xo[i][j][q] = xin[(size_t)(wm * 64 + i * 32 + crow(q, h)) * DM + colb + j * 32];
    if (!(ep.last && isctx)) {
      float* dst = ep.last ? ep.out + (size_t)(m0 - NCTX) * DM : ep.xout + (size_t)m0 * DM;
#pragma unroll
      for (int i = 0; i < 2; ++i)
#pragma unroll
        for (int j = 0; j < 2; ++j)
#pragma unroll
          for (int q = 0; q < 16; ++q) dst[(size_t)(wm * 64 + i * 32 + crow(q, h)) * DM + colb + j * 32] = xo[i][j][q] + gt[j] * acc[i][j][q];
    }
  } else {
#pragma unroll
  for (int i = 0; i < 2; ++i)
#pragma unroll
    for (int j = 0; j < 2; ++j)
#pragma unroll
      for (int q = 0; q < 16; ++q)
        epi_store<EPI>(ep, m0 + wm * 64 + i * 32 + crow(q, h), n0 + wn * 64 + j * 32 + r, acc[i][j][q]);
  }
}

template <int DQK>
NI void attn_item(const bf16_t* __restrict__ Q, const bf16_t* __restrict__ Kp, const bf16_t* __restrict__ VT, int q0, int ntiles,
                  const bf16_t* __restrict__ Z, bf16_t* __restrict__ Yb, int ycol, float scale_log2, char* lds) {
  constexpr int KS = DQK / 16, CPR = DQK / 8, KROW = DQK * 2 + 16, NKC = CPR / 4;
  char* Ks = lds; char* Vs = lds + 64 * KROW;
  const int tid = get_tid(), w = tid >> 6, lane = tid & 63, r = lane & 31, h = lane >> 5;
  bf16x8 qr[KS];
  const bf16_t* qp = Q + (size_t)(q0 + w * 32 + r) * DQK + h * 8;
#pragma unroll
  for (int ks = 0; ks < KS; ++ks) qr[ks] = *(const bf16x8*)(qp + ks * 16);
  f32x16 ot[4];
#pragma unroll
  for (int n = 0; n < 4; ++n)
#pragma unroll
    for (int q = 0; q < 16; ++q) ot[n][q] = 0.f;
  float m = -1e30f, lsum = 0.f;
  u32x4 kreg[NKC], vreg[4];
  const int krow_s = tid >> 2, kcq = tid & 3, vrow_s = tid >> 3, vch = tid & 7;
  const bf16_t* Kg = Kp + (size_t)krow_s * DQK + kcq * 8;
  const bf16_t* Vg = VT + tid * 8;
  char* Kst = Ks + krow_s * KROW + kcq * 16;
  char* Vst = Vs + vrow_s * 144 + vch * 16;
#define A_LOAD(tile) do { _Pragma("unroll") for (int i = 0; i < NKC; ++i) kreg[i] = *(const u32x4*)(Kg + (size_t)(tile) * 64 * DQK + i * 32); \
    _Pragma("unroll") for (int i = 0; i < 4; ++i) vreg[i] = *(const u32x4*)(Vg + (size_t)(tile) * 8192 + i * 2048); } while (0)
#define A_STORE() do { _Pragma("unroll") for (int i = 0; i < NKC; ++i) *(u32x4*)(Kst + i * 64) = kreg[i]; \
    _Pragma("unroll") for (int i = 0; i < 4; ++i) *(u32x4*)(Vst + i * 32 * 144) = vreg[i]; } while (0)
  const char* Krd = Ks + r * KROW + h * 16;
  const char* Vrd = Vs + r * 144 + h * 16;
  A_LOAD(0);
  for (int t = 0; t < ntiles; ++t) {
    __syncthreads();
    A_STORE();
    __syncthreads();
    if (t + 1 < ntiles) A_LOAD(t + 1);
    f32x16 st0, st1;
#pragma unroll
    for (int q = 0; q < 16; ++q) { st0[q] = 0.f; st1[q] = 0.f; }
#pragma unroll
    for (int ks0 = 0; ks0 < KS; ks0 += 2) {
      bf16x8 a0[2], a1[2];
#pragma unroll
      for (int j = 0; j < 2; ++j) { a0[j] = *(const bf16x8*)(Krd + (ks0 + j) * 32); a1[j] = *(const bf16x8*)(Krd + 32 * KROW + (ks0 + j) * 32); }
      __builtin_amdgcn_sched_barrier(0);
#pragma unroll
      for (int j = 0; j < 2; ++j) { st0 = MFMA32(a0[j], qr[ks0 + j], st0); st1 = MFMA32(a1[j], qr[ks0 + j], st1); }
    }
    float mx = st0[0];
#pragma unroll
    for (int q = 1; q < 16; ++q) mx = fmaxf(mx, st0[q]);
#pragma unroll
    for (int q = 0; q < 16; ++q) mx = fmaxf(mx, st1[q]);
    mx = fmaxf(mx, __shfl_xor(mx, 32));
    const float mnew = fmaxf(m, mx * scale_log2);
    const float alpha = __builtin_amdgcn_exp2f(m - mnew);
    m = mnew;
    float ps = 0.f;
#pragma unroll
    for (int q = 0; q < 16; ++q) { st0[q] = __builtin_amdgcn_exp2f(st0[q] * scale_log2 - mnew); ps += st0[q]; }
#pragma unroll
    for (int q = 0; q < 16; ++q) { st1[q] = __builtin_amdgcn_exp2f(st1[q] * scale_log2 - mnew); ps += st1[q]; }
    lsum = lsum * alpha + ps;
    if (!__all(alpha == 1.f)) {
#pragma unroll
      for (int n = 0; n < 4; ++n)
#pragma unroll
        for (int q = 0; q < 16; ++q) ot[n][q] *= alpha;
    }
    bf16x8 pf[4];
    pf[0] = pack8(st0, 0); pf[1] = pack8(st0, 1); pf[2] = pack8(st1, 0); pf[3] = pack8(st1, 1);
#pragma unroll
    for (int n = 0; n < 4; ++n) {
      bf16x8 va[4];
#pragma unroll
      for (int ks = 0; ks < 4; ++ks) va[ks] = *(const bf16x8*)(Vrd + n * 32 * 144 + ks * 32);
      __builtin_amdgcn_sched_barrier(0);
#pragma unroll
      for (int ks = 0; ks < 4; ++ks) ot[n] = MFMA32(va[ks], pf[ks], ot[n]);
    }
  }
#undef A_LOAD
#undef A_STORE
  lsum += __shfl_xor(lsum, 32);
  const float inv = 1.f / lsum;
  const int row = q0 + w * 32 + r;
  uint2 zq[4][4];
#pragma unroll
  for (int n = 0; n < 4; ++n)
#pragma unroll
    for (int g = 0; g < 4; ++g) zq[n][g] = *(const uint2*)(Z + (size_t)row * INP + n * 32 + 8 * g + 4 * h);
#pragma unroll
  for (int n = 0; n < 4; ++n)
#pragma unroll
    for (int g = 0; g < 4; ++g) {
      const int e0 = n * 32 + 8 * g + 4 * h;
      const uint2 zz = zq[n][g];
      float z0 = __uint_as_float(zz.x << 16), z1 = __uint_as_float(zz.x & 0xffff0000u), z2 = __uint_as_float(zz.y << 16), z3 = __uint_as_float(zz.y & 0xffff0000u);
      uint2 o;
      o.x = pk2(ot[n][4 * g + 0] * inv * siluf(z0), ot[n][4 * g + 1] * inv * siluf(z1));
      o.y = pk2(ot[n][4 * g + 2] * inv * siluf(z2), ot[n][4 * g + 3] * inv * siluf(z3));
      *(uint2*)(Yb + tiled_off(row, ycol + e0)) = o;
    }
}

DI void transpose_tile(const float* __restrict__ src, int K, int N, bf16_t* __restrict__ dst, const float* __restrict__ kscale, int k0, int n0, char* lds, int rm_gate = -1, int ldd = 0) {
  const bool tiled = ldd < 0;
  if (ldd == 0) ldd = K;
  float* tile = (float*)lds;
  const int tid = get_tid();
  {
    const int nn = tid & 127, kq = tid >> 7;
    const bool ok = n0 + nn < N;
    float v[32];
#pragma unroll
    for (int i = 0; i < 32; ++i) v[i] = ok ? src[(size_t)(k0 + kq + 2 * i) * N + n0 + nn] : 0.f;
    if (kscale) {
#pragma unroll
      for (int i = 0; i < 32; ++i) v[i] *= kscale[k0 + kq + 2 * i];
    }
#pragma unroll
    for (int i = 0; i < 32; ++i) tile[(kq + 2 * i) * 129 + nn] = v[i];
  }
  __syncthreads();
  {
    const int nn = tid >> 1, kg = tid & 1;
    unsigned o[16];
#pragma unroll
    for (int i = 0; i < 16; ++i) o[i] = pk2(tile[(kg * 32 + 2 * i) * 129 + nn], tile[(kg * 32 + 2 * i + 1) * 129 + nn]);
    const int drow = rm_gate < 0 ? n0 + nn : ((nn >> 6) * 128 + ((nn >> 5) & 1) * 64 + rm_gate * 32 + (nn & 31));
    uint4* d = (uint4*)(tiled ? dst + tiled_off(drow, k0 + kg * 32) : dst + (size_t)drow * ldd + k0 + kg * 32);
#pragma unroll
    for (int i = 0; i < 4; ++i) d[i] = make_uint4(o[4 * i], o[4 * i + 1], o[4 * i + 2], o[4 * i + 3]);
  }
}

NI void phase0(const P& p, unsigned* ctr, int* s_item, char* lds) {
  char* ws = p.ws;
  constexpr int J_IN = 32 * 46, J_OUT = 32 * 16, J_UQ = 6 * 6, J_UKV = 4 * 8, J_LRU = 32;
  constexpr int J_L = J_IN + J_OUT + J_UQ + J_UKV + J_LRU;
  constexpr int N_TR = NL * J_L, N_GEMV = NL * 96;
  ITEMS_STATIC(item, N_GEMV + N_TR) {
    if (item < N_GEMV) {
      const int l = item / 96, nc = item % 96;
      float* sc = (float*)lds;
      for (int k = get_tid(); k < 2048; k += 256) { sc[k] = siluf(p.in[I_C][k]); sc[2048 + k] = siluf(p.in[I_CCTX][k]); }
      __syncthreads();
      const int nl = get_tid() & 63, kq = get_tid() >> 6, n = nc * 64 + nl;
      const float* wp = p.in[I_WADA] + (size_t)l * 2048 * 6144 + n;
      float a0 = 0.f, a1 = 0.f;
      for (int kb = 0; kb < 512; kb += 32) {
        float wv[32];
#pragma unroll
        for (int u = 0; u < 32; ++u) wv[u] = wp[(size_t)(kq + 4 * (kb + u)) * 6144];
#pragma unroll
        for (int u = 0; u < 32; ++u) { const int k = kq + 4 * (kb + u); a0 += sc[k] * wv[u]; a1 += sc[2048 + k] * wv[u]; }
      }
      float* red = (float*)(lds + 16384);
      red[kq * 64 + nl] = a0; red[256 + kq * 64 + nl] = a1;
      __syncthreads();
      if (kq == 0) {
        float b = p.in[I_BADA][l * 6144 + n];
        float* mod = (float*)(ws + WS_MOD) + (size_t)l * 2 * 6144;
        mod[n] = red[nl] + red[64 + nl] + red[128 + nl] + red[192 + nl] + b;
        mod[6144 + n] = red[256 + nl] + red[320 + nl] + red[384 + nl] + red[448 + nl] + b;
      }
    } else {
      int j = item - N_GEMV; const int l = j / J_L; j %= J_L;
      if (j < J_IN) {
        transpose_tile(p.in[I_WIN] + (size_t)l * DM * INW, DM, INW, (bf16_t*)(ws + WS_WTIN) + (size_t)l * INP * LDP, nullptr, (j / 46) * 64, (j % 46) * 128, lds, -1, -1);
      } else if ((j -= J_IN) < J_OUT) {
        transpose_tile(p.in[I_WOUT] + (size_t)l * DM * DM, DM, DM, (bf16_t*)(ws + WS_WTOUT) + (size_t)l * DM * LDP, nullptr, (j / 16) * 64, (j % 16) * 128, lds, -1, -1);
      } else if ((j -= J_OUT) < J_UQ) {
        transpose_tile(p.in[I_MWUQ] + (size_t)l * 384 * 768, 384, 768, (bf16_t*)(ws + WS_WTUQ) + (size_t)l * 768 * 384, p.in[I_MQN] + l * 384, (j / 6) * 64, (j % 6) * 128, lds);
      } else if ((j -= J_UQ) < J_UKV) {
        transpose_tile(p.in[I_MWUKV] + (size_t)l * 256 * 1024, 256, 1024, (bf16_t*)(ws + WS_WTUKV) + (size_t)l * 1024 * 256, p.in[I_MKVN] + l * 256, (j / 8) * 64, (j % 8) * 128, lds);
      } else {
        j -= J_UKV;
        const int mat = j >> 1, tl = j & 1, dir = mat >> 3, gate = (mat >> 2) & 1, blk = mat & 3;
        const float* src = (gate ? p.in[I_LWX] : p.in[I_LWA]) + ((size_t)(l * 2 + dir) * 4 + blk) * 128 * 128;
        bf16_t* dst = (bf16_t*)(ws + WS_WTLRU) + ((size_t)l * 2048 + (dir * 8 + blk * 2) * 128) * 128;
        transpose_tile(src, 128, 128, dst, nullptr, tl * 64, 0, lds, gate);
      }
    }
  }
}

DI const float* xrow_ptr(const P& p, int layer, int t) {
  if (layer == 0) return t < NCTX ? p.in[I_CTX] + (size_t)t * DM : p.in[I_X] + (size_t)(t - NCTX) * DM;
  return (const float*)(p.ws + WS_X) + (size_t)t * DM;
}
NI void phase_norm(const P& p, int l, unsigned* ctr, int* s_item, char* lds) {
  const float* nw = p.in[I_NORMW] + l * DM;
  const float* mod = (const float*)(p.ws + WS_MOD) + (size_t)l * 2 * 6144;
  bf16_t* H = (bf16_t*)(p.ws + WS_H);
  float* red = (float*)lds;
  const int tid = get_tid();
  ITEMS_STATIC(item, T / 4) {
    const int t0 = item * 4;
    float4 v0[4], v1[4];
#pragma unroll
    for (int rr = 0; rr < 4; ++rr) {
      const float* xp = xrow_ptr(p, l, t0 + rr) + tid * 8;
      v0[rr] = *(const float4*)xp; v1[rr] = *(const float4*)(xp + 4);
    }
    const float* md = mod + (t0 < NCTX ? 6144 : 0);
    float wv[8], sc[8], sh[8];
#pragma unroll
    for (int i = 0; i < 8; ++i) { const int c0 = tid * 8 + i; wv[i] = nw[c0]; sc[i] = 1.f + md[2048 + c0]; sh[i] = md[c0]; }
#pragma unroll
    for (int rr = 0; rr < 4; ++rr) {
      float ss = v0[rr].x * v0[rr].x + v0[rr].y * v0[rr].y + v0[rr].z * v0[rr].z + v0[rr].w * v0[rr].w +
                 v1[rr].x * v1[rr].x + v1[rr].y * v1[rr].y + v1[rr].z * v1[rr].z + v1[rr].w * v1[rr].w;
      ss += __shfl_xor(ss, 32); ss = hw_sum(ss);
      if ((tid & 63) == 0) red[rr * 4 + (tid >> 6)] = ss;
    }
    __syncthreads();
#pragma unroll
    for (int rr = 0; rr < 4; ++rr) {
      const float ss = red[rr * 4] + red[rr * 4 + 1] + red[rr * 4 + 2] + red[rr * 4 + 3];
      const float rstd = rsqrtf(ss * (1.f / DM) + EPS);
      const float xv[8] = {v0[rr].x, v0[rr].y, v0[rr].z, v0[rr].w, v1[rr].x, v1[rr].y, v1[rr].z, v1[rr].w};
      unsigned o[4];
#pragma unroll
      for (int i = 0; i < 4; ++i)
        o[i] = pk2(xv[2 * i] * rstd * wv[2 * i] * sc[2 * i] + sh[2 * i], xv[2 * i + 1] * rstd * wv[2 * i + 1] * sc[2 * i + 1] + sh[2 * i + 1]);
      *(uint4*)(H + tiled_off(t0 + rr, tid * 8)) = make_uint4(o[0], o[1], o[2], o[3]);
    }
  }
}

constexpr int RB = 4;
NI void prepA_row(const P& p, int l, int t0) {
  char* ws = p.ws;
  const bf16_t* __restrict__ U = (const bf16_t*)(ws + WS_U);
  const int tid = get_tid(), hw = tid >> 5, ln = tid & 31;
  const bool lat = t0 >= NCTX;
  const int seg_lo = lat ? NCTX : 0, seg_hi = lat ? T : NCTX;
  for (int task = hw; task < 25; task += 8) {
    if (task < 6) {
      const bool isq = task < 4; const int hd = isq ? task : task - 4;
      const bf16_t* src = U + (size_t)t0 * INP + (isq ? O_AQ : O_AK) + hd * 128 + ln;
      const float* nwp = (isq ? p.in[I_AQN] : p.in[I_AKN]) + l * 128 + ln;
      float x[RB][4], nw[4];
#pragma unroll
      for (int rr = 0; rr < RB; ++rr)
#pragma unroll
        for (int j = 0; j < 4; ++j) x[rr][j] = bf2f(src[(size_t)rr * INP + 32 * j]);
#pragma unroll
      for (int j = 0; j < 4; ++j) nw[j] = nwp[32 * j];
      const float invf = exp2f(-(float)ln * (13.287712379549449f / 32.f));
      bf16_t* dst = (bf16_t*)(ws + (isq ? WS_QA : WS_KA)) + ((size_t)hd * T + t0) * 128 + ln;
#pragma unroll
      for (int rr = 0; rr < RB; ++rr) {
        float ss = x[rr][0] * x[rr][0] + x[rr][1] * x[rr][1] + x[rr][2] * x[rr][2] + x[rr][3] * x[rr][3];
        ss = hw_sum(ss);
        const float rstd = rsqrtf(ss * (1.f / 128.f) + EPS);
#pragma unroll
        for (int j = 0; j < 4; ++j) x[rr][j] = x[rr][j] * rstd * nw[j];
        if (lat) {
          const int tt = t0 + rr - NCTX, rpos = tt >> 6, cpos = tt & 63;
          float sn, c;
          sincos_rev((float)rpos * invf, sn, c);
          float a = x[rr][0] * c - x[rr][1] * sn, b = x[rr][0] * sn + x[rr][1] * c; x[rr][0] = a; x[rr][1] = b;
          sincos_rev((float)cpos * invf, sn, c);
          a = x[rr][2] * c - x[rr][3] * sn; b = x[rr][2] * sn + x[rr][3] * c; x[rr][2] = a; x[rr][3] = b;
        }
#pragma unroll
        for (int j = 0; j < 4; ++j) dst[rr * 128 + 32 * j] = f2bf(x[rr][j]);
      }
    } else if (task < 8) {
      const int hd = task - 6;
      const bf16_t* src = U + (size_t)t0 * INP + O_AV + hd * 128 + ln;
      bf16_t v[RB][4];
#pragma unroll
      for (int rr = 0; rr < RB; ++rr)
#pragma unroll
        for (int j = 0; j < 4; ++j) v[rr][j] = src[(size_t)rr * INP + 32 * j];
#pragma unroll
      for (int rr = 0; rr < RB; ++rr) {
        const int t = t0 + rr;
        bf16_t* dst = (bf16_t*)(ws + WS_VAT) + (size_t)hd * 128 * T + (size_t)(t >> 6) * 8192 + (permkey(t) & 63);
#pragma unroll
        for (int j = 0; j < 4; ++j) dst[(ln + 32 * j) * 64] = v[rr][j];
      }
    } else if (task < 24) {
      const bool islru = task < 12;
      const int sg = islru ? task - 8 : task - 12;
      const int cbase = sg * 128 + ln, ucol = (islru ? O_BX : O_CQKV) + cbase, cwn = islru ? 512 : 1536;
      const float* cw = (islru ? p.in[I_LCW] + (size_t)l * 4 * 512 : p.in[I_DCW] + (size_t)l * 4 * 1536) + cbase;
      float u[RB + 3][4], w[4][4];
#pragma unroll
      for (int i = 0; i < RB + 3; ++i) {
        const int rrow = t0 - 2 + i; const bool ok = rrow >= seg_lo && rrow < seg_hi;
#pragma unroll
        for (int j = 0; j < 4; ++j) u[i][j] = ok ? bf2f(U[(size_t)rrow * INP + ucol + 32 * j]) : 0.f;
      }
#pragma unroll
      for (int tap = 0; tap < 4; ++tap)
#pragma unroll
        for (int j = 0; j < 4; ++j) w[tap][j] = cw[tap * cwn + 32 * j];
      if (islru) {
        float cb[4];
#pragma unroll
        for (int j = 0; j < 4; ++j) cb[j] = p.in[I_LCB][l * 512 + cbase + 32 * j];
#pragma unroll
        for (int rr = 0; rr < RB; ++rr)
#pragma unroll
          for (int j = 0; j < 4; ++j) {
            float acc = cb[j];
#pragma unroll
            for (int tap = 0; tap < 4; ++tap) acc += w[tap][j] * u[rr + tap][j];
            const size_t o = (size_t)(t0 + rr) * 512 + cbase + 32 * j;
            ((float*)(ws + WS_XL))[o] = acc;
            ((bf16_t*)(ws + WS_XLB))[o] = f2bf(acc);
          }
      } else {
#pragma unroll
        for (int rr = 0; rr < RB; ++rr) {
          float x[4]; float ss = 0.f;
#pragma unroll
          for (int j = 0; j < 4; ++j) {
            float acc = 0.f;
#pragma unroll
            for (int tap = 0; tap < 4; ++tap) acc += w[tap][j] * u[rr + tap][j];
            x[j] = siluf(acc); ss += x[j] * x[j];
          }
          if (sg < 8) {
            ss = hw_sum(ss);
            float sc = rsqrtf(ss + EPS); if (sg < 4) sc *= 0.08838834764831845f;
#pragma unroll
            for (int j = 0; j < 4; ++j) x[j] *= sc;
          }
#pragma unroll
          for (int j = 0; j < 4; ++j) ((float*)(ws + WS_CQKV))[(size_t)(t0 + rr) * 1536 + cbase + 32 * j] = x[j];
        }
      }
    } else {
      const int rr = ln >> 3, dir = (ln >> 2) & 1, hd = ln & 3, t = t0 + rr;
      const float* ab = (const float*)(ws + WS_AB) + (size_t)t * 16 + dir * 8;
      const float beta = 1.f / (1.f + expf(-ab[hd]));
      const float g = -expf(p.in[I_DALOG][l * 8 + dir * 4 + hd]) * softplusf(ab[4 + hd] + p.in[I_DDT][l * 8 + dir * 4 + hd]);
      float* bg = (float*)(ws + WS_BG) + (size_t)t * 16 + dir * 8;
      bg[hd] = beta; bg[4 + hd] = g;
    }
  }
}

constexpr int RBD = 2;
NI void prepD_row(const P& p, int l, int t0) {
  char* ws = p.ws;
  const bf16_t* __restrict__ U = (const bf16_t*)(ws + WS_U);
  const int tid = get_tid(), hw = tid >> 5, ln = tid & 31;
  const bool lat = t0 >= NCTX;
  for (int task = hw; task < 12; task += 8) {
    const int hd = task & 3;
    const bool isq = task < 4;
    float ssi[RBD];
    if (isq) {
#pragma unroll
      for (int rr = 0; rr < RBD; ++rr) { float a = 0.f;
#pragma unroll
        for (int j = 0; j < 12; ++j) { const float v = bf2f(U[(size_t)(t0 + rr) * INP + O_DCQ + ln + 32 * j]); a += v * v; }
        ssi[rr] = a; }
    } else {
#pragma unroll
      for (int rr = 0; rr < RBD; ++rr) { float a = 0.f;
#pragma unroll
        for (int j = 0; j < 8; ++j) { const float v = bf2f(U[(size_t)(t0 + rr) * INP + O_DCKV + ln + 32 * j]); a += v * v; }
        ssi[rr] = a; }
    }
    float x[RBD][6];
    if (task < 8) {
      if (isq) {
        const bf16_t* src = (const bf16_t*)(ws + WS_QDR) + (size_t)t0 * 768 + hd * 192 + ln;
#pragma unroll
        for (int rr = 0; rr < RBD; ++rr)
#pragma unroll
          for (int j = 0; j < 6; ++j) x[rr][j] = bf2f(src[(size_t)rr * 768 + 32 * j]);
      } else {
        const bf16_t* src = (const bf16_t*)(ws + WS_KVDR) + (size_t)t0 * 1024 + hd * 256 + ln;
#pragma unroll
        for (int rr = 0; rr < RBD; ++rr) {
#pragma unroll
          for (int j = 0; j < 4; ++j) x[rr][j] = bf2f(src[(size_t)rr * 1024 + 32 * j]);
          x[rr][4] = bf2f(U[(size_t)(t0 + rr) * INP + O_DKR + ln]); x[rr][5] = bf2f(U[(size_t)(t0 + rr) * INP + O_DKR + 32 + ln]);
        }
      }
    } else {
      const bf16_t* src = (const bf16_t*)(ws + WS_KVDR) + (size_t)t0 * 1024 + hd * 256 + 128 + ln;
#pragma unroll
      for (int rr = 0; rr < RBD; ++rr) {
#pragma unroll
        for (int j = 0; j < 4; ++j) x[rr][j] = bf2f(src[(size_t)rr * 1024 + 32 * j]);
        x[rr][4] = 0.f; x[rr][5] = 0.f;
      }
    }
    float nwv[6];
    const float* nwp = (isq ? p.in[I_MQQK] : p.in[I_MKQK]) + l * 192 + ln;
#pragma unroll
    for (int j = 0; j < 6; ++j) nwv[j] = nwp[32 * j];
    const float invf = exp2f(-(float)(ln & 15) * (13.287712379549449f / 16.f));
#pragma unroll
    for (int rr = 0; rr < RBD; ++rr) {
      const int t = t0 + rr;
      const float rstd_in = rsqrtf(hw_sum(ssi[rr]) * (isq ? (1.f / 384.f) : (1.f / 256.f)) + EPS);
      if (task < 8) {
        const int nsc = isq ? 6 : 4;
#pragma unroll
        for (int j = 0; j < 6; ++j) if (j < nsc) x[rr][j] *= rstd_in;
        float ss = 0.f;
#pragma unroll
        for (int j = 0; j < 6; ++j) ss += x[rr][j] * x[rr][j];
        const float rstd = rsqrtf(hw_sum(ss) * (1.f / 192.f) + EPS);
#pragma unroll
        for (int j = 0; j < 6; ++j) x[rr][j] = x[rr][j] * rstd * nwv[j];
        if (lat) {
          const int tt = t - NCTX, rpos = tt >> 6, cpos = tt & 63;
          float sn, c;
          {
            sincos_rev((float)rpos * invf, sn, c);
            const float other = __shfl_xor(x[rr][4], 16);
            x[rr][4] = (ln < 16) ? (x[rr][4] * c - other * sn) : (other * sn + x[rr][4] * c);
          }
          {
            sincos_rev((float)cpos * invf, sn, c);
            const float other = __shfl_xor(x[rr][5], 16);
            x[rr][5] = (ln < 16) ? (x[rr][5] * c - other * sn) : (other * sn + x[rr][5] * c);
          }
        }
        bf16_t* dst = (bf16_t*)(ws + (isq ? WS_QD : WS_KD)) + ((size_t)hd * T + t) * 192 + ln;
#pragma unroll
        for (int j = 0; j < 6; ++j) dst[32 * j] = f2bf(x[rr][j]);
      } else {
        bf16_t* dst = (bf16_t*)(ws + WS_VDT) + (size_t)hd * 128 * T + (size_t)(t >> 6) * 8192 + (permkey(t) & 63);
#pragma unroll
        for (int j = 0; j < 4; ++j) dst[(ln + 32 * j) * 64] = f2bf(x[rr][j] * rstd_in);
      }
    }
  }
}

NI void dn_chunk_local(const P& p, int dh, int n, char* lds) {
  char* ws = p.ws;
  const int dir = dh >> 2, hd = dh & 3, tid = get_tid();
  float* kS = (float*)lds;
  float* qS = kS + 64 * 33;
  float* Ls = qS + 64 * 33;
  float* gcS = Ls + 64 * 64;
  float* bS = gcS + 64;
  float* egS = bS + 64;
  const float* CQ = (const float*)(ws + WS_CQKV);
  const float* BG = (const float*)(ws + WS_BG);
  const int row0 = pos2row(dir, n * 64), rstep = dir ? -1 : 1;
  const long rstride = (long)rstep * 1536;
  if (tid < 64) {
    const int row = row0 + rstep * tid;
    bS[tid] = BG[(size_t)row * 16 + dir * 8 + hd];
    gcS[tid] = BG[(size_t)row * 16 + dir * 8 + 4 + hd];
  }
  __syncthreads();
  if (tid == 0) { float a = 0.f; for (int i = 0; i < 64; ++i) { a += gcS[i]; gcS[i] = a; } }
  __syncthreads();
  if (tid < 64) egS[tid] = expf(gcS[tid]);
  const int c = tid & 63, sg = tid >> 6;
  float akk[16], aqk[16];
#pragma unroll
  for (int i = 0; i < 16; ++i) { akk[i] = 0.f; aqk[i] = 0.f; }
  float pq[8], pk[8];
#define CL_LOAD(d0) do { _Pragma("unroll") for (int i = 0; i < 8; ++i) { const int idx = tid + 256 * i, rr = idx >> 5, dd = idx & 31; \
      const float* src = CQ + (size_t)(row0 + rstep * rr) * 1536 + hd * 128 + (d0) + dd; pq[i] = src[0]; pk[i] = src[512]; } } while (0)
  CL_LOAD(0);
  for (int d0 = 0; d0 < 128; d0 += 32) {
    __syncthreads();
#pragma unroll
    for (int i = 0; i < 8; ++i) { const int idx = tid + 256 * i, rr = idx >> 5, dd = idx & 31; qS[rr * 33 + dd] = pq[i]; kS[rr * 33 + dd] = pk[i]; }
    __syncthreads();
    if (d0 + 32 < 128) CL_LOAD(d0 + 32);
    for (int d = 0; d < 32; ++d) {
      const float kc = kS[c * 33 + d], qc = qS[c * 33 + d];
#pragma unroll
      for (int i = 0; i < 16; ++i) { const float ks = kS[(sg * 16 + i) * 33 + d]; akk[i] += kc * ks; aqk[i] += qc * ks; }
    }
  }
#undef CL_LOAD
  {
    const float gc_c = gcS[c], beta_c = bS[c];
    bf16_t* QKo = (bf16_t*)(ws + WS_DQK) + ((size_t)(dh * NCH + n) * 64 + c) * 64;
#pragma unroll
    for (int i = 0; i < 16; ++i) {
      const int s = sg * 16 + i;
      const float dec = (c >= s) ? expf(gc_c - gcS[s]) : 0.f;
      Ls[c * 64 + s] = (c > s) ? beta_c * akk[i] * dec : 0.f;
      QKo[s] = f2bf(aqk[i] * dec);
    }
  }
  __syncthreads();
  {
    const int col = tid;
    float x[64];
    const float* src = CQ + (size_t)row0 * 1536 + hd * 128 + (col < 128 ? 1024 + col : 512 + (col - 128));
#pragma unroll
    for (int hb = 0; hb < 2; ++hb) {
#pragma unroll
      for (int i = hb * 32; i < hb * 32 + 32; ++i) {
        const float f = (col < 128) ? bS[i] : bS[i] * egS[i];
        x[i] = src[(long)i * rstride] * f;
      }
      __builtin_amdgcn_sched_barrier(0);
#pragma unroll
      for (int i = hb * 32; i < hb * 32 + 32; ++i) {
        float a = x[i];
#pragma unroll
        for (int j = 0; j < i; ++j) a -= Ls[i * 64 + j] * x[j];
        x[i] = a;
        if ((i & 3) == 3) __builtin_amdgcn_sched_barrier(0);
      }
    }
    if (col < 128) {
      uint4* dst = (uint4*)((bf16_t*)(ws + WS_DU) + ((size_t)(dh * NCH + n) * 128 + col) * 64);
#pragma unroll
      for (int i = 0; i < 8; ++i) dst[i] = make_uint4(pk2(x[8 * i], x[8 * i + 1]), pk2(x[8 * i + 2], x[8 * i + 3]), pk2(x[8 * i + 4], x[8 * i + 5]), pk2(x[8 * i + 6], x[8 * i + 7]));
    } else {
      bf16_t* dst = (bf16_t*)(ws + WS_DW) + ((size_t)dh * T + n * 64) * 128 + (col - 128);
#pragma unroll
      for (int i = 0; i < 64; ++i) dst[(size_t)i * 128] = f2bf(x[i]);
    }
  }
  {
    const float glast = gcS[63];
    const int d = tid & 127, cg2 = tid >> 7;
    bf16_t* qd = (bf16_t*)(ws + WS_DQ) + ((size_t)dh * T + n * 64) * 128;
    {
      float tq[32];
      const float* qsrc = CQ + (size_t)(row0 + rstep * (cg2 * 32)) * 1536 + hd * 128 + d;
#pragma unroll
      for (int i = 0; i < 32; ++i) tq[i] = qsrc[(long)i * rstride];
#pragma unroll
      for (int i = 0; i < 32; ++i) qd[(size_t)(cg2 * 32 + i) * 128 + d] = f2bf(tq[i] * egS[cg2 * 32 + i]);
    }
    bf16_t* kt = (bf16_t*)(ws + WS_DKT) + ((size_t)dh * NCH + n) * 128 * 64;
    const float kf = expf(glast - gcS[c]);
    const float* ksrc = CQ + (size_t)(row0 + rstep * c) * 1536 + 512 + hd * 128;
    {
      float4 tk[8];
#pragma unroll
      for (int i = 0; i < 8; ++i) tk[i] = *(const float4*)(ksrc + sg * 32 + 4 * i);
#pragma unroll
      for (int i = 0; i < 8; ++i) {
        bf16_t* kd = kt + (sg * 32 + 4 * i) * 64 + c;
        kd[0] = f2bf(tk[i].x * kf); kd[64] = f2bf(tk[i].y * kf); kd[128] = f2bf(tk[i].z * kf); kd[192] = f2bf(tk[i].w * kf);
      }
    }
    if (tid == 0) ((float*)(ws + WS_DGL))[dh * NCH + n] = glast;
  }
}

NI void dn_scan(const P& p, int dh, int sl, char* lds) {
  char* ws = p.ws;
  char* ST = lds;
  char* VT = lds + 8704;
  const int tid = get_tid(), w = tid >> 6, lane = tid & 63, r = lane & 31, h = lane >> 5, mt = w & 1;
  const bf16_t* __restrict__ UT = (const bf16_t*)(ws + WS_DU) + (size_t)dh * NCH * 8192 + (size_t)(sl * 32 + r) * 64 + mt * 32 + 4 * h;
  const bf16_t* __restrict__ A1 = (const bf16_t*)(ws + (w < 2 ? WS_DW : WS_DQ)) + (size_t)dh * T * 128 + (size_t)(mt * 32 + r) * 128 + h * 8;
  const bf16_t* __restrict__ QK = (const bf16_t*)(ws + WS_DQK) + (size_t)dh * NCH * 4096 + (mt * 32 + r) * 64 + h * 8;
  const bf16_t* __restrict__ KT = (const bf16_t*)(ws + WS_DKT) + (size_t)dh * NCH * 8192 + (w * 32 + r) * 64 + h * 8;
  const float* __restrict__ GL = (const float*)(ws + WS_DGL) + dh * NCH;
  float* __restrict__ DO = (float*)(ws + WS_DO) + (size_t)dh * T * 128 + sl * 32 + r;
  for (int i = tid; i < 8704 / 4; i += 256) ((unsigned*)ST)[i] = 0u;
  f32x16 S;
#pragma unroll
  for (int q = 0; q < 16; ++q) S[q] = 0.f;
  bf16x8 c_a1[8], c_qk[4], c_kt[4], n_a1[8], n_qk[4], n_kt[4];
  uint2 c_u[4], n_u[4];
  float c_gl, n_gl;
#define DN_LOAD(X, nn) do { \
    _Pragma("unroll") for (int ks = 0; ks < 8; ++ks) X##_a1[ks] = *(const bf16x8*)(A1 + (size_t)(nn) * 8192 + ks * 16); \
    _Pragma("unroll") for (int ks = 0; ks < 4; ++ks) X##_kt[ks] = *(const bf16x8*)(KT + (size_t)(nn) * 8192 + ks * 16); \
    if (w >= 2) { _Pragma("unroll") for (int ks = 0; ks < 4; ++ks) X##_qk[ks] = *(const bf16x8*)(QK + (size_t)(nn) * 4096 + ks * 16); } \
    else { _Pragma("unroll") for (int g = 0; g < 4; ++g) X##_u[g] = *(const uint2*)(UT + (size_t)(nn) * 8192 + 8 * g); } \
    X##_gl = GL[nn]; } while (0)
#pragma unroll
  for (int ks = 0; ks < 4; ++ks) { c_qk[ks] = (bf16x8)(0); n_qk[ks] = (bf16x8)(0); c_u[ks] = make_uint2(0u, 0u); n_u[ks] = make_uint2(0u, 0u); }
  DN_LOAD(c, 0);
  __syncthreads();
  for (int n = 0; n < NCH; ++n) {
    if (n + 1 < NCH) DN_LOAD(n, n + 1);
    const float dec = expf(c_gl);
    f32x16 acc0, acc1;
#pragma unroll
    for (int q = 0; q < 16; ++q) { acc0[q] = 0.f; acc1[q] = 0.f; }
#pragma unroll
    for (int ks = 0; ks < 8; ks += 2) {
      bf16x8 b0 = *(const bf16x8*)(ST + r * 272 + h * 16 + ks * 32);
      bf16x8 b1 = *(const bf16x8*)(ST + r * 272 + h * 16 + (ks + 1) * 32);
      acc0 = MFMA32(c_a1[ks], b0, acc0);
      acc1 = MFMA32(c_a1[ks + 1], b1, acc1);
    }
#pragma unroll
    for (int q = 0; q < 16; ++q) acc0[q] += acc1[q];
    if (w < 2) {
#pragma unroll
      for (int g = 0; g < 4; ++g) {
        const float u0 = __uint_as_float(c_u[g].x << 16), u1 = __uint_as_float(c_u[g].x & 0xffff0000u);
        const float u2 = __uint_as_float(c_u[g].y << 16), u3 = __uint_as_float(c_u[g].y & 0xffff0000u);
        uint2 o;
        o.x = pk2(u0 - acc0[4 * g + 0], u1 - acc0[4 * g + 1]);
        o.y = pk2(u2 - acc0[4 * g + 2], u3 - acc0[4 * g + 3]);
        *(uint2*)(VT + r * 144 + (mt * 4 + g) * 16 + h * 8) = o;
      }
    }
    __syncthreads();
    bf16x8 vb[4];
#pragma unroll
    for (int ks = 0; ks < 4; ++ks) vb[ks] = *(const bf16x8*)(VT + r * 144 + h * 16 + ks * 32);
    if (w >= 2) {
#pragma unroll
      for (int ks = 0; ks < 4; ++ks) acc0 = MFMA32(c_qk[ks], vb[ks], acc0);
#pragma unroll
      for (int q = 0; q < 16; ++q) DO[(size_t)(n * 64 + mt * 32 + crow(q, h)) * 128] = acc0[q];
    }
#pragma unroll
    for (int q = 0; q < 16; ++q) S[q] *= dec;
#pragma unroll
    for (int ks = 0; ks < 4; ++ks) S = MFMA32(c_kt[ks], vb[ks], S);
#pragma unroll
    for (int g = 0; g < 4; ++g) {
      uint2 o;
      o.x = pk2(S[4 * g + 0], S[4 * g + 1]); o.y = pk2(S[4 * g + 2], S[4 * g + 3]);
      *(uint2*)(ST + r * 272 + (w * 4 + g) * 16 + h * 8) = o;
    }
#pragma unroll
    for (int ks = 0; ks < 8; ++ks) c_a1[ks] = n_a1[ks];
#pragma unroll
    for (int ks = 0; ks < 4; ++ks) { c_kt[ks] = n_kt[ks]; c_qk[ks] = n_qk[ks]; c_u[ks] = n_u[ks]; }
    c_gl = n_gl;
    __syncthreads();
  }
#undef DN_LOAD
}

NI void lru_scan(const P& p, int l, int dir, int cgp, char* lds) {
  char* ws = p.ws;
  const int tid = get_tid(), ch = tid & 7, seg = tid >> 3, c = cgp * 8 + ch;
  const float* __restrict__ LA = (const float*)(ws + WS_G) + (size_t)dir * T * 512 + c;
  const float* __restrict__ LB = (const float*)(ws + WS_G) + (size_t)(2 + dir) * T * 512 + c;
  float* __restrict__ HL = (float*)(ws + WS_HL) + (size_t)dir * T * 512 + c;
  float* sA = (float*)lds; float* sB = sA + 256;
  const int p0 = seg * 264;
  float Aa = 1.f, Bb = 0.f;
  for (int q = 0; q < 264; q += 12) {
    float av[12], bv[12];
#pragma unroll
    for (int u = 0; u < 12; ++u) { const size_t ro = (size_t)pos2row(dir, p0 + q + u) * 512; av[u] = LA[ro]; bv[u] = LB[ro]; }
#pragma unroll
    for (int u = 0; u < 12; ++u) { Bb = av[u] * Bb + bv[u]; Aa *= av[u]; }
  }
  sA[seg * 8 + ch] = Aa; sB[seg * 8 + ch] = Bb;
  __syncthreads();
  float hh = 0.f;
  for (int s2 = 0; s2 < seg; ++s2) hh = sA[s2 * 8 + ch] * hh + sB[s2 * 8 + ch];
  for (int q = 0; q < 264; q += 12) {
    float av[12], bv[12]; size_t ro[12];
#pragma unroll
    for (int u = 0; u < 12; ++u) { ro[u] = (size_t)pos2row(dir, p0 + q + u) * 512; av[u] = LA[ro[u]]; bv[u] = LB[ro[u]]; }
#pragma unroll
    for (int u = 0; u < 12; ++u) { hh = av[u] * hh + bv[u]; HL[ro[u]] = hh; }
  }
  (void)l;
}

NI void post_row(const P& p, int l, int t0) {
  char* ws = p.ws;
  const bf16_t* __restrict__ U = (const bf16_t*)(ws + WS_U);
  bf16_t* Y = (bf16_t*)(ws + WS_Y);
  const int tid = get_tid(), hw = tid >> 5, ln = tid & 31;
  if (hw < 4) {
    const int hd = hw;
    float x[RB][4], z[RB][4], nw[4];
#pragma unroll
    for (int rr = 0; rr < RB; ++rr) {
      const int t = t0 + rr, pb = t < NCTX ? NCTX - 1 - t : (T + NCTX - 1) - t;
      const float* of = (const float*)(ws + WS_DO) + ((size_t)hd * T + t) * 128 + ln;
      const float* ob = (const float*)(ws + WS_DO) + ((size_t)(4 + hd) * T + pb) * 128 + ln;
#pragma unroll
      for (int j = 0; j < 4; ++j) { x[rr][j] = of[32 * j] + ob[32 * j]; z[rr][j] = bf2f(U[(size_t)t * INP + O_CZ + hd * 128 + ln + 32 * j]); }
    }
#pragma unroll
    for (int j = 0; j < 4; ++j) nw[j] = p.in[I_DNW][l * 128 + ln + 32 * j];
#pragma unroll
    for (int rr = 0; rr < RB; ++rr) {
      float ss = x[rr][0] * x[rr][0] + x[rr][1] * x[rr][1] + x[rr][2] * x[rr][2] + x[rr][3] * x[rr][3];
      const float rstd = rsqrtf(hw_sum(ss) * (1.f / 128.f) + EPS);
#pragma unroll
      for (int j = 0; j < 4; ++j) Y[tiled_off(t0 + rr, 1024 + hd * 128 + ln + 32 * j)] = f2bf(x[rr][j] * rstd * nw[j] * siluf(z[rr][j]));
    }
  } else {
    const int sg = hw - 4;
    float hsum[RB][4], z[RB][4];
#pragma unroll
    for (int rr = 0; rr < RB; ++rr) {
      const float* h0 = (const float*)(ws + WS_HL) + (size_t)(t0 + rr) * 512 + sg * 128 + ln;
      const float* h1 = h0 + (size_t)T * 512;
#pragma unroll
      for (int j = 0; j < 4; ++j) { hsum[rr][j] = h0[32 * j] + h1[32 * j]; z[rr][j] = bf2f(U[(size_t)(t0 + rr) * INP + O_BZ + sg * 128 + ln + 32 * j]); }
    }
#pragma unroll
    for (int rr = 0; rr < RB; ++rr)
#pragma unroll
      for (int j = 0; j < 4; ++j) Y[tiled_off(t0 + rr, 512 + sg * 128 + ln + 32 * j)] = f2bf(hsum[rr][j] * siluf(z[rr][j]));
  }
}

constexpr int N_PHASES = 1 + NL * 7;
__global__ void __launch_bounds__(256, 2) mega(P p) {
  __shared__ __attribute__((aligned(16))) char lds[73728];
  __shared__ int s_item;
  char* ws = p.ws;
  unsigned* ctrs = (unsigned*)(ws + WS_CTR);
  unsigned n_x = 0, nxcd = 0;
  const unsigned myx = (unsigned)xcc_id();
  if (threadIdx.x == 0) __hip_atomic_fetch_add((unsigned*)(ws + WS_BAR) + 32 * (20 + myx), 1u, __ATOMIC_RELAXED, __HIP_MEMORY_SCOPE_AGENT);
  for (int ph2 = 2 * p.ph_lo; ph2 < 2 * p.ph_hi; ++ph2) {
    const int ph = ph2 >> 1;
    const bool rep_this = (REP_K >= 0 && ph > 0 && (ph - 1) % 7 == REP_K) || (REP_K == 7 && ph == 0);
    if ((ph2 & 1) && !rep_this) continue;
    unsigned* ctr = ctrs + ph + 32 * (ph2 & 1);
    if (ph == 0 && EN(0)) {
      phase0(p, ctr, &s_item, lds);
    } else {
      const int l = (ph - 1) / 7, k = (ph - 1) % 7;
      const float* modl = (const float*)(ws + WS_MOD) + (size_t)l * 2 * 6144;
      bf16_t* U = (bf16_t*)(ws + WS_U);
      if (k == 0 && EN(1)) {
        phase_norm(p, l, ctr, &s_item, lds);
      } else if (k == 1 && EN(2)) {
        Epi e{}; e.cb = U; e.cf = (float*)(ws + WS_AB);
        const bf16_t* Bt = (const bf16_t*)(ws + WS_WTIN) + (size_t)l * INP * LDP;
        const int g0 = xcc_id();
        for (int gi = 0; gi < 8; ++gi) {
          const int g = (g0 + gi) & 7;
          unsigned* gctr = ctrs + 128 + ph2 * 8 + g;
          int tm, tn;
          int i = next_item(gctr, &s_item);
          while (xcd_tile(g, i, 66, 46, tm, tn)) {
            unsigned pend = 0;
            if (threadIdx.x == 0) pend = atomicAdd(gctr, 1u);
            gemm_tile<0, true>((const bf16_t*)(ws + WS_H), LDP, Bt, LDP, DM, tm * 128, tn * 128, lds, e);
            __syncthreads();
            if (threadIdx.x == 0) s_item = (int)pend;
            __syncthreads();
            i = s_item;
          }
        }
      } else if (k == 2 && EN(3)) {
        constexpr int NG = 66 * 6 + 66 * 8;
        ITEMS_STATIC(item, NG + T / 4) {
          if (item < 66 * 6) {
            Epi e{}; e.cb = (bf16_t*)(ws + WS_QDR); e.ldc = 768;
            gemm_tile<1>(U + O_DCQ, INP, (const bf16_t*)(ws + WS_WTUQ) + (size_t)l * 768 * 384, 384, 384, (item / 6) * 128, (item % 6) * 128, lds, e);
          } else if (item < NG) {
            const int it = item - 66 * 6;
            Epi e{}; e.cb = (bf16_t*)(ws + WS_KVDR); e.ldc = 1024;
            gemm_tile<1>(U + O_DCKV, INP, (const bf16_t*)(ws + WS_WTUKV) + (size_t)l * 1024 * 256, 256, 256, (it / 8) * 128, (it % 8) * 128, lds, e);
          } else {
            const int r0 = (item - NG) * 4;
            prepA_row(p, l, r0);
          }
        }
      } else if (k == 3 && EN(4)) {
        constexpr int NC = 8 * NCH, NGT = 66 * 16;
        ITEMS_STATIC(item, NC + NGT + T / 4) {
          if (item < NC) {
            if (ENS(0)) dn_chunk_local(p, item / NCH, item % NCH, lds);
          } else if (item < NC + NGT) {
            const int it = item - NC, mtile = it >> 4, ntile = it & 15;
            Epi e{}; e.bias0 = p.in[I_LBA] + l * 1024; e.bias1 = p.in[I_LBX] + l * 1024; e.lam = p.in[I_LLAM] + l * 1024;
            e.xl = (const float*)(ws + WS_XL); e.la = (float*)(ws + WS_G); e.lb = (float*)(ws + WS_G) + (size_t)2 * T * 512;
            gemm_tile<2>((const bf16_t*)(ws + WS_XLB) + ((ntile >> 1) & 3) * 128, 512, (const bf16_t*)(ws + WS_WTLRU) + (size_t)l * 2048 * 128, 128, 128,
                         mtile * 128, ntile * 128, lds, e);
          } else {
            const int r0 = (item - NC - NGT) * 4;
            prepD_row(p, l, r0); prepD_row(p, l, r0 + 2);
          }
        }
      } else if (k == 4 && EN(5)) {
        const int g0 = xcc_id();
        for (int gi = 0; gi < 8; ++gi) {
        const int g = (g0 + gi) & 7;
        unsigned* gctr = ctrs + 128 + ph2 * 8 + g;
        const int tot = (g < 4) ? 84 : 88;
        for (int i = next_item(gctr, &s_item); i < tot; i = next_item(gctr, &s_item)) {
          if (g < 4) {
            if (i < 16) { const int li = 64 + g * 16 + i; for (int rp = 0; rp < (REP_SUB == 2 ? 2 : 1); ++rp) { lru_scan(p, l, li >> 6, li & 63, lds); __syncthreads(); } }
            else if (i < 20) {
              const int it = g * 4 + (i - 16), mixer = it >> 3, hd = (it >> 1) & 3, qb = it & 1;
              if (mixer == 0)
                attn_item<192>((const bf16_t*)(ws + WS_QD) + (size_t)hd * T * 192, (const bf16_t*)(ws + WS_KD) + (size_t)hd * T * 192,
                               (const bf16_t*)(ws + WS_VDT) + (size_t)hd * 128 * T, qb * 128, 4, U + O_DZ + hd * 128,
                               (bf16_t*)(ws + WS_Y), 1536 + hd * 128, 0.07216878364870322f * 1.4426950408889634f, lds);
              else
                attn_item<128>((const bf16_t*)(ws + WS_QA) + (size_t)hd * T * 128, (const bf16_t*)(ws + WS_KA) + (size_t)(hd >> 1) * T * 128,
                               (const bf16_t*)(ws + WS_VAT) + (size_t)(hd >> 1) * 128 * T, qb * 128, 4, U + O_AZ + hd * 128,
                               (bf16_t*)(ws + WS_Y), hd * 128, 0.08838834764831845f * 1.4426950408889634f, lds);
            } else {
              const int hd = g, qb = i - 20;
              for (int rp = 0; rp < (REP_SUB == 3 ? 2 : 1); ++rp)
              attn_item<192>((const bf16_t*)(ws + WS_QD) + (size_t)hd * T * 192, (const bf16_t*)(ws + WS_KD) + (size_t)hd * T * 192,
                             (const bf16_t*)(ws + WS_VDT) + (size_t)hd * 128 * T, NCTX + qb * 128, NCH, U + O_DZ + hd * 128,
                             (bf16_t*)(ws + WS_Y), 1536 + hd * 128, 0.07216878364870322f * 1.4426950408889634f, lds);
            }
          } else {
            if (i < 8) { const int di = (g - 4) * 8 + i; for (int rp = 0; rp < (REP_SUB == 1 ? 2 : 1); ++rp) { dn_scan(p, di >> 2, di & 3, lds); __syncthreads(); } }
            else if (i < 24) { const int li = (g - 4) * 16 + (i - 8); for (int rp = 0; rp < (REP_SUB == 2 ? 2 : 1); ++rp) { lru_scan(p, l, li >> 6, li & 63, lds); __syncthreads(); } }
            else {
              const int hd = g - 4, qb = i - 24;
              for (int rp = 0; rp < (REP_SUB == 3 ? 2 : 1); ++rp)
              attn_item<128>((const bf16_t*)(ws + WS_QA) + (size_t)hd * T * 128, (const bf16_t*)(ws + WS_KA) + (size_t)(hd >> 1) * T * 128,
                             (const bf16_t*)(ws + WS_VAT) + (size_t)(hd >> 1) * 128 * T, NCTX + qb * 128, NCH, U + O_AZ + hd * 128,
                             (bf16_t*)(ws + WS_Y), hd * 128, 0.08838834764831845f * 1.4426950408889634f, lds);
            }
          }
        }
        }
      } else if (k == 5 && EN(6)) {
        ITEMS_STATIC(item, T / 4)
          post_row(p, l, item * 4);
      } else if (k == 6 && EN(7)) {
        Epi e{};
        e.xin_ctx = (l == 0) ? p.in[I_CTX] : (const float*)(ws + WS_X);
        e.xin_lat = (l == 0) ? p.in[I_X] : (const float*)(ws + WS_X) + (size_t)NCTX * DM;
        e.xout = (float*)(ws + WS_X); e.out = p.out;
        e.gate_lat = modl + 4096; e.gate_ctx = modl + 6144 + 4096; e.last = (l == NL - 1);
        const bf16_t* Bt = (const bf16_t*)(ws + WS_WTOUT) + (size_t)l * DM * LDP;
        const int g0 = xcc_id();
        for (int gi = 0; gi < 8; ++gi) {
          const int g = (g0 + gi) & 7;
          unsigned* gctr = ctrs + 128 + ph2 * 8 + g;
          int tm, tn;
          const int mt_n = e.last ? 64 : 66, mt_0 = e.last ? 2 : 0;
          int i = next_item(gctr, &s_item);
          while (xcd_tile(g, i, mt_n, 16, tm, tn)) {
            unsigned pend = 0;
            if (threadIdx.x == 0) pend = atomicAdd(gctr, 1u);
            gemm_tile<3, true>((const bf16_t*)(ws + WS_Y), LDP, Bt, LDP, DM, (tm + mt_0) * 128, tn * 128, lds, e);
            __syncthreads();
            if (threadIdx.x == 0) s_item = (int)pend;
            __syncthreads();
            i = s_item;
          }
        }
      }
    }
    if ((ph + 1 < p.ph_hi) || (rep_this && !(ph2 & 1))) {
      if (ph == 0 && !(ph2 & 1)) {
        cg::this_grid().sync();
        for (unsigned x = 0; x < 8; ++x) {
          const unsigned c = __hip_atomic_load((unsigned*)(ws + WS_BAR) + 32 * (20 + x), __ATOMIC_RELAXED, __HIP_MEMORY_SCOPE_AGENT);
          nxcd += (c > 0); if (x == myx) n_x = c;
        }
        n_x = __builtin_amdgcn_readfirstlane(n_x); nxcd = __builtin_amdgcn_readfirstlane(nxcd);
      } else if (REP_K >= 0) cg::this_grid().sync();
      else grid_barrier((unsigned*)(ws + WS_BAR), (unsigned)ph, myx, n_x, nxcd);
    }
  }
}

extern "C" void kernel_launch(void* const* d_in, const int* in_sizes, int n_in, void* d_out, int out_size, void* d_ws, size_t ws_size, hipStream_t stream) {
  static int grid_blocks = 0;
  if (!grid_blocks) {
    int dev = 0, cus = 0, per_cu = 0;
    hipGetDevice(&dev);
    hipDeviceGetAttribute(&cus, hipDeviceAttributeMultiprocessorCount, dev);
    hipOccupancyMaxActiveBlocksPerMultiprocessor(&per_cu, mega, 256, 0);
    if (per_cu < 1) per_cu = 1;
    if (per_cu > 2) per_cu = 2;
    grid_blocks = cus * per_cu;
    if (ws_size < WS_END) fprintf(stderr, "kernel_launch: workspace too small: %zu < %zu\n", ws_size, (size_t)WS_END);
    fprintf(stderr, "kernel_launch: grid %d (cus %d x %d), ws need %zu have %zu\n", grid_blocks, cus, per_cu, (size_t)WS_END, ws_size);
  }
  if (ws_size < WS_END || n_in < 28) return;
  hipMemsetAsync((char*)d_ws + WS_CTR, 0, 8192, stream);
  P p{};
  for (int i = 0; i < 28; ++i) p.in[i] = (const float*)d_in[i];
  p.out = (float*)d_out; p.ws = (char*)d_ws;
#if MEGA
  p.ph_lo = 0; p.ph_hi = N_PHASES;
  void* args[] = {&p};
  hipError_t e = hipLaunchCooperativeKernel((void*)mega, dim3(grid_blocks), dim3(256), args, 0, stream);
  if (e != hipSuccess) fprintf(stderr, "cooperative launch failed: %s (grid %d)\n", hipGetErrorString(e), grid_blocks);
#else
  for (int ph = 0; ph < N_PHASES; ++ph) {
    p.ph_lo = ph; p.ph_hi = ph + 1;
    hipLaunchKernelGGL(mega, dim3(grid_blocks), dim3(256), 0, stream, p);
  }
#endif
}
```
